# Optimizing an MI355X kernel written in HIP

```python
import jax, jax.numpy as jnp
from jax import lax
import numpy as np

D_MODEL = 2048
BATCH = 4
SEQ = 2048
DEPTH = 2
DEC_BATCH = 32
DEC_SEQ = 16
PAST_LEN = 1024

CHUNK = 64
N_MIXERS = 2
N_CONV_LAYERS = (DEPTH + 1) // 2
N_SGU_LAYERS = DEPTH // 2
CONV_W = 3
CONV_GROUPS = 16
SGU_CHUNK = 128
SGU_WIDTH = D_MODEL
SGU_GROUPS = 16
SGU_GROUP_DIM = SGU_WIDTH // SGU_GROUPS
D_FF = ((8 * D_MODEL // 3 + 255) // 256) * 256
EPS = 1e-6

kernel_name = "hybrid_shortconv_chunk_sgu_stream_step"


def rms_norm(x, g):
    xf = x.astype(jnp.float32)
    y = xf * lax.rsqrt(jnp.mean(xf * xf, axis=-1, keepdims=True) + EPS)
    return (y * g.astype(jnp.float32)).astype(x.dtype)


def layer_norm(x, g, b):
    xf = x.astype(jnp.float32)
    mu = jnp.mean(xf, axis=-1, keepdims=True)
    xc = xf - mu
    y = xc * lax.rsqrt(jnp.mean(xc * xc, axis=-1, keepdims=True) + EPS)
    return (y * g.astype(jnp.float32) + b.astype(jnp.float32)).astype(x.dtype)


def short_conv_mixer(h, hist, w_in, conv_w, w_out):
    L = h.shape[1]
    proj = h @ w_in
    gate_b, gate_c, z = jnp.split(proj, 3, axis=-1)
    cz = gate_c * z
    xp = jnp.concatenate([hist.astype(cz.dtype), cz], axis=1)
    conv = conv_w[0] * xp[:, 0:L] + conv_w[1] * xp[:, 1:L + 1] + conv_w[2] * xp[:, 2:L + 2]
    y = (gate_b * conv) @ w_out
    return y, xp[:, L:]


def chunk_sgu_mixer(h, w_in, b_in, ln_g, ln_b, w_s, b_s, w_out):
    bsz, L, _ = h.shape
    n = min(L, SGU_CHUNK)
    zz = jax.nn.gelu(h @ w_in + b_in, approximate=False)
    u, v = jnp.split(zz, 2, axis=-1)
    v = layer_norm(v, ln_g, ln_b)
    vb = v.reshape(bsz, L // n, n, SGU_GROUPS, SGU_GROUP_DIM)
    w = jnp.tril(w_s[:, :n, :n])
    mixed = jnp.einsum('gij,bcjgd->bcigd', w, vb) + b_s[:, :n].T[None, None, :, :, None]
    y = (u * mixed.reshape(bsz, L, SGU_WIDTH)) @ w_out
    return y, v


def swiglu_ffn(h, w_gate, w_up, w_down):
    return (jax.nn.silu(h @ w_gate) * (h @ w_up)) @ w_down


def setup_inputs(seed: int = 0) -> dict:
    key = jax.random.key(seed)
    ks = jax.random.split(key, 24)
    f32 = jnp.float32
    nrm = lambda k, shape, scale: jax.random.normal(k, shape, f32) * scale
    D = D_MODEL
    return {
        "x_prompt": nrm(ks[0], (BATCH, SEQ, D), 1.0),
        "x_sample": nrm(ks[1], (DEC_BATCH, DEC_SEQ, D), 1.0),
        "cache_conv": nrm(ks[2], (N_CONV_LAYERS, DEC_BATCH, CONV_W - 1, D), 1.0),
        "norm_mix_pre": 1.0 + nrm(ks[3], (DEPTH, D), 0.05),
        "norm_mix_post": 1.0 + nrm(ks[4], (DEPTH, D), 0.05),
        "norm_ffn_pre": 1.0 + nrm(ks[5], (DEPTH, D), 0.05),
        "norm_ffn_post": 1.0 + nrm(ks[6], (DEPTH, D), 0.05),
        "a_w_in": nrm(ks[7], (N_CONV_LAYERS, D, 3 * D), D ** -0.5),
        "a_conv_w": nrm(ks[8], (N_CONV_LAYERS, CONV_W, D), CONV_W ** -0.5),
        "a_w_out": nrm(ks[9], (N_CONV_LAYERS, D, D), D ** -0.5),
        "b_w_in": nrm(ks[10], (N_SGU_LAYERS, D, 2 * SGU_WIDTH), D ** -0.5),
        "b_b_in": nrm(ks[11], (N_SGU_LAYERS, 2 * SGU_WIDTH), 0.02),
        "b_ln_g": 1.0 + nrm(ks[12], (N_SGU_LAYERS, SGU_WIDTH), 0.05),
        "b_ln_b": nrm(ks[13], (N_SGU_LAYERS, SGU_WIDTH), 0.02),
        "b_w_s": nrm(ks[14], (N_SGU_LAYERS, SGU_GROUPS, SGU_CHUNK, SGU_CHUNK), SGU_CHUNK ** -0.5),
        "b_b_s": 1.0 + nrm(ks[15], (N_SGU_LAYERS, SGU_GROUPS, SGU_CHUNK), 0.1),
        "b_w_out": nrm(ks[16], (N_SGU_LAYERS, SGU_WIDTH, D), SGU_WIDTH ** -0.5),
        "ffn_w_gate": nrm(ks[17], (DEPTH, D, D_FF), D ** -0.5),
        "ffn_w_up": nrm(ks[18], (DEPTH, D, D_FF), D ** -0.5),
        "ffn_w_down": nrm(ks[19], (DEPTH, D_FF, D), D_FF ** -0.5),
    }


def reference(x_prompt, x_sample, cache_conv, norm_mix_pre, norm_mix_post, norm_ffn_pre,
              norm_ffn_post, a_w_in, a_conv_w, a_w_out, b_w_in, b_b_in, b_ln_g, b_ln_b,
              b_w_s, b_b_s, b_w_out, ffn_w_gate, ffn_w_up, ffn_w_down):
    xp, xs = x_prompt, x_sample
    conv_prompt, conv_sample, sgu_sample = [], [], []
    for i in range(DEPTH):
        j = i // N_MIXERS
        hp = rms_norm(xp, norm_mix_pre[i])
        hs = rms_norm(xs, norm_mix_pre[i])
        if i % N_MIXERS == 0:
            zero_hist = jnp.zeros((xp.shape[0], CONV_W - 1, D_MODEL), xp.dtype)
            mp, st_p = short_conv_mixer(hp, zero_hist, a_w_in[j], a_conv_w[j], a_w_out[j])
            ms, st_s = short_conv_mixer(hs, cache_conv[j], a_w_in[j], a_conv_w[j], a_w_out[j])
            conv_prompt.append(st_p)
            conv_sample.append(st_s)
        else:
            mp, _ = chunk_sgu_mixer(hp, b_w_in[j], b_b_in[j], b_ln_g[j], b_ln_b[j],
                                    b_w_s[j], b_b_s[j], b_w_out[j])
            ms, v_s = chunk_sgu_mixer(hs, b_w_in[j], b_b_in[j], b_ln_g[j], b_ln_b[j],
                                      b_w_s[j], b_b_s[j], b_w_out[j])
            sgu_sample.append(v_s)
        xp = xp + rms_norm(mp, norm_mix_post[i])
        xs = xs + rms_norm(ms, norm_mix_post[i])
        xp = xp + rms_norm(swiglu_ffn(rms_norm(xp, norm_ffn_pre[i]), ffn_w_gate[i], ffn_w_up[i],
                                      ffn_w_down[i]), norm_ffn_post[i])
        xs = xs + rms_norm(swiglu_ffn(rms_norm(xs, norm_ffn_pre[i]), ffn_w_gate[i], ffn_w_up[i],
                                      ffn_w_down[i]), norm_ffn_post[i])
    state_conv_prompt = jnp.stack(conv_prompt)
    state_conv_sample = jnp.stack(conv_sample)
    state_sgu_v_sample = jnp.stack(sgu_sample)
    return (xp, xs, state_conv_prompt, state_conv_sample, state_sgu_v_sample)
```

```cpp
#include <hip/hip_runtime.h>
#include <hip/hip_cooperative_groups.h>
#include <cstdio>
namespace cg = cooperative_groups;

#define LAS __attribute__((address_space(3)))
typedef unsigned short bf16_t;
typedef short bf16x8 __attribute__((ext_vector_type(8)));
typedef float f32x4 __attribute__((ext_vector_type(4)));
typedef float f32x2 __attribute__((ext_vector_type(2)));
typedef unsigned u32x4 __attribute__((ext_vector_type(4)));
typedef unsigned u32x2 __attribute__((ext_vector_type(2)));

#define GSYNC() xcd_barrier((unsigned*)(pp->ws + WS_BAR), (volatile LAS unsigned*)(lds + LDS_STAGE))

constexpr int D = 2048, MP = 8192, MS = 512, M = MP + MS, FF = 5632;
constexpr float EPS = 1e-6f;
constexpr int NTHREADS = 512, NWAVES = 8;
constexpr int LDS_STAGE = 131072;
constexpr int LDS_BYTES = LDS_STAGE + 16;

constexpr size_t WS_WAIN = 0;
constexpr size_t WS_WAOUT = WS_WAIN + (size_t)6144 * 2048 * 2;
constexpr size_t WS_WBIN = WS_WAOUT + (size_t)2048 * 2048 * 2;
constexpr size_t WS_WBOUT = WS_WBIN + (size_t)4096 * 2048 * 2;
constexpr size_t WS_WGU0 = WS_WBOUT + (size_t)2048 * 2048 * 2;
constexpr size_t WS_WGU1 = WS_WGU0 + (size_t)11264 * 2048 * 2;
constexpr size_t WS_WDN0 = WS_WGU1 + (size_t)11264 * 2048 * 2;
constexpr size_t WS_WDN1 = WS_WDN0 + (size_t)2048 * 5632 * 2;
constexpr size_t WS_H = WS_WDN1 + (size_t)2048 * 5632 * 2;
constexpr size_t WS_BIG = WS_H + (size_t)M * 2048 * 2;
constexpr size_t WS_YIN = WS_BIG + (size_t)M * 5632 * 2;
constexpr size_t WS_MB = WS_YIN + (size_t)M * 2048 * 2;
constexpr size_t WS_STATS = WS_MB + (size_t)M * 2048 * 2;
constexpr size_t WS_XB = WS_STATS + (size_t)M * 64 * 4;
constexpr size_t WS_BAR = WS_XB + (size_t)M * 2048 * 2;
constexpr size_t WS_END = WS_BAR + 3456 * 4;

constexpr size_t O_Y = 0;
constexpr size_t O_SCP = (size_t)M * D;
constexpr size_t O_SCS = O_SCP + 4 * 2 * 2048;
constexpr size_t O_SGU = O_SCS + 32 * 2 * 2048;

struct Params { const float* in[20]; float* out; unsigned char* ws; };
typedef const __attribute__((address_space(4))) Params* PP;
#define FRESH(pp) asm volatile("" : "+s"(pp) :: "memory")

__device__ __forceinline__ unsigned cvt_pk_bf16(float lo, float hi) { unsigned r; asm volatile("v_cvt_pk_bf16_f32 %0, %1, %2" : "=v"(r) : "v"(lo), "v"(hi)); return r; }
__device__ __forceinline__ float bf_lo(unsigned w) { return __uint_as_float(w << 16); }
__device__ __forceinline__ float bf_hi(unsigned w) { return __uint_as_float(w & 0xffff0000u); }
__device__ __forceinline__ float wave_sum(float v) {
#pragma unroll
    for (int o = 1; o < 64; o <<= 1) v += __shfl_xor(v, o);
    return v;
}
__device__ __forceinline__ f32x2 gelu_pk(f32x2 v) {
    const f32x2 av = __builtin_elementwise_abs(v), d = av * 0.2316418882f + 1.0f;
    f32x2 t; t.x = __builtin_amdgcn_rcpf(d.x); t.y = __builtin_amdgcn_rcpf(d.y);
    f32x2 q = t * 0.5307027145f + (-0.7265760135f); q = q * t + 0.7107068705f; q = q * t + (-0.142248368f); q = q * t + 0.127414796f; q = q * t;
    const f32x2 s = (v * v) * (-0.72134752044f);
    f32x2 e; e.x = __builtin_amdgcn_exp2f(s.x); e.y = __builtin_amdgcn_exp2f(s.y);
    const f32x2 m = v * (q * e), r = v - m;
    f32x2 o; o.x = v.x < 0.f ? m.x : r.x; o.y = v.y < 0.f ? m.y : r.y; return o;
}
__device__ __forceinline__ f32x4 gelu4(f32x4 v) { f32x2 a = gelu_pk((f32x2){v[0], v[1]}), b = gelu_pk((f32x2){v[2], v[3]}); return (f32x4){a.x, a.y, b.x, b.y}; }
__device__ __forceinline__ float silu1(float x) { return x * __builtin_amdgcn_rcpf(1.0f + __builtin_amdgcn_exp2f(-1.4426950408889634f * x)); }
__device__ __forceinline__ f32x4 silu_mul4(f32x4 g, f32x4 u) { return (f32x4){silu1(g[0]) * u[0], silu1(g[1]) * u[1], silu1(g[2]) * u[2], silu1(g[3]) * u[3]}; }

namespace pg8 {
constexpr int BM = 256, BK = 64, HALF = 128, HTB = HALF * BK * 2, NXCD = 8, WGM = 8;
__device__ __forceinline__ int lds_byte(int r, int c) { const int st = (r >> 4) * 2 + (c >> 5), rr = r & 15, cc = c & 31, ob = rr * 64 + cc * 2; return st * 1024 + (ob ^ (((ob >> 9) & 1) << 5)); }
__device__ __forceinline__ void stage_rc(int b, int& R, int& C) { const int st = b / 1024, sb = b % 1024, swz = sb ^ (((sb >> 9) & 1) << 5); R = (st >> 1) * 16 + swz / 64; C = (st & 1) * 32 + (swz % 64) / 2; }
__device__ __forceinline__ int perm32(int rho) { const int n = rho >> 4, i = rho & 15; return 8 * (i >> 2) + 4 * n + (i & 3); }

struct Unit { int pm, pn; };
struct Gemm { const bf16_t* A; const bf16_t* Bt; int M, N, K; };
struct StaticOrder {
    int nM, nN, nwg, G, c;
    __device__ void init(int M_, int N_, int G_, int c_) { nM = M_ / BM; nN = N_ / BM; nwg = nM * nN; G = G_; c = c_; }
    __device__ bool next(int i, Unit& u) const {
        const long L = (long)i * G + c; if (L >= nwg) return false;
        int wgid = (int)L; { const int q = nwg / NXCD, r = nwg % NXCD, xcd = wgid % NXCD, off = wgid / NXCD; wgid = (xcd < r ? xcd * (q + 1) : r * (q + 1) + (xcd - r) * q) + off; }
        const int nig = WGM * nN, gid = wgid / nig, fm = gid * WGM, gsz = (nM - fm) < WGM ? (nM - fm) : WGM;
        u.pm = fm + ((wgid % nig) % gsz); u.pn = (wgid % nig) / gsz; return true;
    }
};

template <class Epi>
__device__ __forceinline__ void gemm_phase(LAS unsigned char* lds, const Gemm g, const StaticOrder& S, const Epi& E) {
    int tid = threadIdx.x; asm volatile("" : "+v"(tid));
    const int wid = __builtin_amdgcn_readfirstlane(tid >> 6), lane = tid & 63, wr = wid >> 2, wc = wid & 3, fr = lane & 15, fq = lane >> 4;
    const int K = g.K, nt = K / BK;
    unsigned voffA[2], voffB[2];
#pragma unroll
    for (int i = 0; i < 2; ++i) { int R, C; stage_rc(tid * 16 + i * 8192, R, C); const int Rb = (R & ~31) + perm32(R & 31);
        voffA[i] = (unsigned)(R * K + C) * 2u; voffB[i] = (unsigned)(Rb * K + C) * 2u; }
    const size_t kstep = (size_t)(BK * 2);
    const size_t hstep = (size_t)HALF * K * 2;
    const size_t tstep = 2 * hstep;
    const unsigned ldsw = (unsigned)wid * 1024u;
    const int aoff = lds_byte(wr * 64 + fr, fq * 8), boff = lds_byte(wc * 32 + fr, fq * 8);
#define PG8_SA(b, h) (((b) * 2 + (h)) * HTB)
#define PG8_SB(b, h) ((4 + (b) * 2 + (h)) * HTB)
#define PG8_STAGE(bufoff, gbase, voff) do { _Pragma("unroll") for (int _i = 0; _i < 2; ++_i) \
        __builtin_amdgcn_global_load_lds((const unsigned*)((const char*)(gbase) + (voff)[_i]), (LAS unsigned*)(lds + (bufoff) + ldsw + _i * 8192), 16, 0, 0); } while (0)
#define PG8_LDA(dst, b, h) do { _Pragma("unroll") for (int m = 0; m < 4; ++m) _Pragma("unroll") for (int k = 0; k < 2; ++k) dst[m][k] = *(const LAS bf16x8*)(lds + PG8_SA(b, h) + aoff + m * 2048 + k * 1024); } while (0)
#define PG8_LDB(dst, b, h) do { _Pragma("unroll") for (int n = 0; n < 2; ++n) _Pragma("unroll") for (int k = 0; k < 2; ++k) dst[n][k] = *(const LAS bf16x8*)(lds + PG8_SB(b, h) + boff + n * 2048 + k * 1024); } while (0)
#define PG8_MMA(ai, bj, At, Bt) do { __builtin_amdgcn_s_setprio(1); _Pragma("unroll") for (int m = 0; m < 4; ++m) _Pragma("unroll") for (int n = 0; n < 2; ++n) _Pragma("unroll") for (int k = 0; k < 2; ++k) \
        acc[ai][bj][m][n] = __builtin_amdgcn_mfma_f32_16x16x32_bf16(Bt[n][k], At[m][k], acc[ai][bj][m][n], 0, 0, 0); __builtin_amdgcn_s_setprio(0); } while (0)
#define PG8_WAIT_V(n) asm volatile("s_waitcnt vmcnt(" #n ")" ::: "memory")
#define PG8_WAIT_L(n) asm volatile("s_waitcnt lgkmcnt(" #n ")" ::: "memory")
#define PG8_BAR __builtin_amdgcn_s_barrier()
#define PG8_SCHED __builtin_amdgcn_sched_barrier(0)
    Unit cur, nxt; int ui = 0;
    if (!S.next(0, cur)) return;
    f32x4 acc[2][2][4][2];
#pragma unroll
    for (int a = 0; a < 2; ++a)
#pragma unroll
        for (int b = 0; b < 2; ++b)
#pragma unroll
            for (int m = 0; m < 4; ++m)
#pragma unroll
                for (int n = 0; n < 2; ++n) acc[a][b][m][n] = (f32x4){0.f, 0.f, 0.f, 0.f};
    bf16x8 At[4][2], B0[2][2], B1[2][2];
    const char* cA = (const char*)g.A + (size_t)cur.pm * tstep; const char* cB = (const char*)g.Bt + (size_t)cur.pn * tstep;
    PG8_STAGE(PG8_SB(0, 0), cB, voffB); PG8_STAGE(PG8_SA(0, 0), cA, voffA); PG8_STAGE(PG8_SB(0, 1), cB + hstep, voffB); PG8_STAGE(PG8_SA(0, 1), cA + hstep, voffA);
    if (wr == 1) PG8_BAR;
    PG8_WAIT_V(4); PG8_BAR;
    PG8_STAGE(PG8_SB(1, 0), cB + kstep, voffB); PG8_STAGE(PG8_SA(1, 0), cA + kstep, voffA); PG8_STAGE(PG8_SB(1, 1), cB + hstep + kstep, voffB);
    PG8_WAIT_V(6); PG8_BAR;
    for (;;) {
        const bool has_next = S.next(ui + 1, nxt);
        const char* nA = has_next ? (const char*)g.A + (size_t)nxt.pm * tstep : cA; const char* nB = has_next ? (const char*)g.Bt + (size_t)nxt.pn * tstep : cB;
        for (int t = 0; t < nt; t += 2) {
            const bool last = (t == nt - 2);
            const char* a1 = cA + (size_t)(t + 1) * kstep;
            const char* a2 = last ? nA : cA + (size_t)(t + 2) * kstep; const char* b2 = last ? nB : cB + (size_t)(t + 2) * kstep;
            const char* a3 = a2 + kstep; const char* b3 = b2 + kstep;
            PG8_LDB(B0, 0, 0); PG8_SCHED; PG8_LDA(At, 0, 0); PG8_STAGE(PG8_SA(1, 1), a1 + hstep, voffA);
            PG8_WAIT_L(8); PG8_BAR; PG8_WAIT_L(0); PG8_MMA(0, 0, At, B0); PG8_BAR; PG8_SCHED;
            PG8_LDB(B1, 0, 1); PG8_STAGE(PG8_SB(0, 0), b2, voffB);
            PG8_BAR; PG8_WAIT_L(0); PG8_MMA(0, 1, At, B1); PG8_BAR;
            PG8_LDA(At, 0, 1); PG8_STAGE(PG8_SA(0, 0), a2, voffA);
            PG8_BAR; PG8_WAIT_L(0); PG8_MMA(1, 0, At, B0); PG8_BAR; PG8_SCHED;
            PG8_STAGE(PG8_SB(0, 1), b2 + hstep, voffB);
            PG8_WAIT_V(6); PG8_BAR; PG8_MMA(1, 1, At, B1); PG8_BAR;
            PG8_LDB(B0, 1, 0); PG8_SCHED; PG8_LDA(At, 1, 0); PG8_STAGE(PG8_SA(0, 1), a2 + hstep, voffA);
            PG8_WAIT_L(8); PG8_BAR; PG8_WAIT_L(0); PG8_MMA(0, 0, At, B0); PG8_BAR; PG8_SCHED;
            PG8_LDB(B1, 1, 1); PG8_STAGE(PG8_SB(1, 0), b3, voffB);
            PG8_BAR; PG8_WAIT_L(0); PG8_MMA(0, 1, At, B1); PG8_BAR;
            PG8_LDA(At, 1, 1); PG8_STAGE(PG8_SA(1, 0), a3, voffA);
            PG8_BAR; PG8_WAIT_L(0); PG8_MMA(1, 0, At, B0); PG8_BAR; PG8_SCHED;
            PG8_STAGE(PG8_SB(1, 1), b3 + hstep, voffB);
            PG8_WAIT_V(6); PG8_BAR; PG8_MMA(1, 1, At, B1); PG8_BAR;
        }
        E(acc, cur, wr, wc, fr, fq);
        if (!has_next) break;
#pragma unroll
        for (int a = 0; a < 2; ++a)
#pragma unroll
            for (int b = 0; b < 2; ++b)
#pragma unroll
                for (int m = 0; m < 4; ++m)
#pragma unroll
                    for (int n = 0; n < 2; ++n) acc[a][b][m][n] = (f32x4){0.f, 0.f, 0.f, 0.f};
        cur = nxt; cA = nA; cB = nB; ++ui;
    }
    PG8_WAIT_V(0);
    if (wr == 0) PG8_BAR;
    PG8_BAR;
#undef PG8_SA
#undef PG8_SB
#undef PG8_STAGE
#undef PG8_LDA
#undef PG8_LDB
#undef PG8_MMA
#undef PG8_WAIT_V
#undef PG8_WAIT_L
#undef PG8_BAR
#undef PG8_SCHED
}
}
using pg8::Unit;

__device__ __forceinline__ u32x4 pack8(f32x4 v0, f32x4 v1) { u32x4 w; w.x = cvt_pk_bf16(v0[0], v0[1]); w.y = cvt_pk_bf16(v0[2], v0[3]); w.z = cvt_pk_bf16(v1[0], v1[1]); w.w = cvt_pk_bf16(v1[2], v1[3]); return w; }

struct EpiPlain {
    bf16_t* O; int ldc;
    __device__ __forceinline__ void operator()(const f32x4 (&acc)[2][2][4][2], const Unit& u, int wr, int wc, int fr, int fq) const {
        const int row0 = u.pm * 256 + wr * 64 + fr, col0 = u.pn * 256 + wc * 32 + 8 * fq;
#pragma unroll
        for (int ai = 0; ai < 2; ++ai)
#pragma unroll
            for (int m = 0; m < 4; ++m) { bf16_t* rowp = O + (size_t)(row0 + ai * 128 + m * 16) * ldc + col0;
#pragma unroll
                for (int bj = 0; bj < 2; ++bj) *(u32x4*)(rowp + bj * 128) = pack8(acc[ai][bj][m][0], acc[ai][bj][m][1]); }
    }
};
struct EpiGU {
    bf16_t* O;
    __device__ __forceinline__ void operator()(const f32x4 (&acc)[2][2][4][2], const Unit& u, int wr, int wc, int fr, int fq) const {
        const int row0 = u.pm * 256 + wr * 64 + fr, col0 = u.pn * 128 + wc * 32 + 8 * fq;
#pragma unroll
        for (int ai = 0; ai < 2; ++ai)
#pragma unroll
            for (int m = 0; m < 4; ++m) { bf16_t* rowp = O + (size_t)(row0 + ai * 128 + m * 16) * FF + col0;
                const f32x4 o0 = silu_mul4(acc[ai][0][m][0], acc[ai][1][m][0]), o1 = silu_mul4(acc[ai][0][m][1], acc[ai][1][m][1]);
                *(u32x4*)rowp = pack8(o0, o1); }
    }
};
struct EpiCZ {
    bf16_t* GB; bf16_t* CZ; float* scp; float* scs;
    __device__ __forceinline__ void operator()(const f32x4 (&acc)[2][2][4][2], const Unit& u, int wr, int wc, int fr, int fq) const {
        const int row0 = u.pm * 256 + wr * 64 + fr;
        if (u.pn < 16) {
            const int col0 = u.pn * 128 + wc * 32 + 8 * fq;
#pragma unroll
            for (int ai = 0; ai < 2; ++ai)
#pragma unroll
                for (int m = 0; m < 4; ++m) { const int r = row0 + ai * 128 + m * 16;
                    const f32x4 c0 = acc[ai][0][m][0] * acc[ai][1][m][0], c1 = acc[ai][0][m][1] * acc[ai][1][m][1];
                    *(u32x4*)(CZ + (size_t)r * D + col0) = pack8(c0, c1);
                    float* sp = nullptr;
                    if (r < MP) { const int t = r & 2047; if (t >= 2046) sp = scp + (size_t)((r >> 11) * 2 + (t - 2046)) * D; }
                    else { const int t = r & 15; if (t >= 14) sp = scs + (size_t)(((r - MP) >> 4) * 2 + (t - 14)) * D; }
                    if (sp) { *(f32x4*)(sp + col0) = c0; *(f32x4*)(sp + col0 + 4) = c1; } }
        } else {
            const int col0 = (u.pn - 16) * 256 + wc * 32 + 8 * fq;
#pragma unroll
            for (int ai = 0; ai < 2; ++ai)
#pragma unroll
                for (int m = 0; m < 4; ++m) { bf16_t* rowp = GB + (size_t)(row0 + ai * 128 + m * 16) * D + col0;
#pragma unroll
                    for (int bj = 0; bj < 2; ++bj) *(u32x4*)(rowp + bj * 128) = pack8(acc[ai][bj][m][0], acc[ai][bj][m][1]); }
        }
    }
};
struct EpiGelu {
    bf16_t* O; const float* bias; float* stats;
    __device__ __forceinline__ void operator()(const f32x4 (&acc)[2][2][4][2], const Unit& u, int wr, int wc, int fr, int fq) const {
        const int row0 = u.pm * 256 + wr * 64 + fr, col0 = u.pn * 256 + wc * 32 + 8 * fq;
        f32x4 bv[2][2];
#pragma unroll
        for (int bj = 0; bj < 2; ++bj)
#pragma unroll
            for (int n = 0; n < 2; ++n) bv[bj][n] = *(const f32x4*)(bias + col0 + bj * 128 + 4 * n);
#pragma unroll
        for (int ai = 0; ai < 2; ++ai)
#pragma unroll
            for (int m = 0; m < 4; ++m) { const int r = row0 + ai * 128 + m * 16; bf16_t* rowp = O + (size_t)r * 4096 + col0; float s = 0.f, ss = 0.f;
#pragma unroll
                for (int bj = 0; bj < 2; ++bj) { const f32x4 v0 = gelu4(acc[ai][bj][m][0] + bv[bj][0]), v1 = gelu4(acc[ai][bj][m][1] + bv[bj][1]);
                    s += (v0[0] + v0[1]) + (v0[2] + v0[3]) + (v1[0] + v1[1]) + (v1[2] + v1[3]);
                    ss += (v0[0] * v0[0] + v0[1] * v0[1]) + (v0[2] * v0[2] + v0[3] * v0[3]) + (v1[0] * v1[0] + v1[1] * v1[1]) + (v1[2] * v1[2] + v1[3] * v1[3]);
                    *(u32x4*)(rowp + bj * 128) = pack8(v0, v1); }
                if (u.pn >= 8) { s += __shfl_xor(s, 16); s += __shfl_xor(s, 32); ss += __shfl_xor(ss, 16); ss += __shfl_xor(ss, 32);
                    if (fq == 0) *(f32x2*)(stats + ((size_t)r * 32 + (u.pn - 8) * 4 + wc) * 2) = (f32x2){s, ss}; } }
    }
};

__device__ __forceinline__ void transpose_item(const float* W, int K, int N, bf16_t* WT, int mode, LAS float* scr, int item, int lane) {
    const int nblk = N / 32, kb = item / nblk, nb = item % nblk, k0 = 64 * kb, n0 = 32 * nb;
    int row0;
    if (mode == 0) row0 = n0;
    else if (mode == 1) row0 = 256 * (n0 >> 7) + (n0 & 127);
    else if (mode == 2) row0 = 256 * (n0 >> 7) + 128 + (n0 & 127);
    else { const int part = n0 >> 11, c = n0 & 2047; row0 = part == 0 ? 4096 + c : (256 * (c >> 7) + (part == 2 ? 128 : 0) + (c & 127)); }
#pragma unroll 8
    for (int i = 0; i < 32; ++i) { const int kk = 2 * i + (lane >> 5); scr[kk * 33 + (lane & 31)] = __builtin_nontemporal_load(W + (size_t)(k0 + kk) * N + n0 + (lane & 31)); }
    asm volatile("s_waitcnt lgkmcnt(0)" ::: "memory");
    const int c = lane & 7;
#pragma unroll
    for (int j = 0; j < 4; ++j) { const int n = (lane >> 3) + 8 * j; const LAS float* s = scr + (8 * c) * 33 + n;
        u32x4 o; o.x = cvt_pk_bf16(s[0 * 33], s[1 * 33]); o.y = cvt_pk_bf16(s[2 * 33], s[3 * 33]); o.z = cvt_pk_bf16(s[4 * 33], s[5 * 33]); o.w = cvt_pk_bf16(s[6 * 33], s[7 * 33]);
        __builtin_nontemporal_store(o, (u32x4*)(WT + (size_t)(row0 + n) * K + k0 + 8 * c)); }
    asm volatile("s_waitcnt lgkmcnt(0)" ::: "memory");
}

constexpr int I_AIN = 32 * 192, I_SQ = 32 * 64, I_BIN = 32 * 128, I_GU = 32 * 176, I_DN = 88 * 64;
constexpr int CV_P0 = I_AIN + I_SQ, CV_T1 = CV_P0 + 2 * I_GU, CV_T3 = CV_T1 + I_DN + I_BIN + I_SQ, CV_T8 = CV_T3 + 2 * I_GU, CV_T10 = CV_T8 + I_DN;
__device__ __forceinline__ void convert_items(PP pp, LAS unsigned char* lds, int lo, int hi, int w, int nw, int wave, int lane) {
    LAS float* scr = (LAS float*)(lds + wave * 8448);
    unsigned char* ws = pp->ws;
    for (int it = lo + w; it < hi; it += nw) {
        int r = it;
        if (r < I_AIN) { transpose_item(pp->in[7], D, 3 * D, (bf16_t*)(ws + WS_WAIN), 3, scr, r, lane); continue; } r -= I_AIN;
        if (r < I_SQ) { transpose_item(pp->in[9], D, D, (bf16_t*)(ws + WS_WAOUT), 0, scr, r, lane); continue; } r -= I_SQ;
        if (r < I_GU) { transpose_item(pp->in[17], D, FF, (bf16_t*)(ws + WS_WGU0), 1, scr, r, lane); continue; } r -= I_GU;
        if (r < I_GU) { transpose_item(pp->in[18], D, FF, (bf16_t*)(ws + WS_WGU0), 2, scr, r, lane); continue; } r -= I_GU;
        if (r < I_DN) { transpose_item(pp->in[19], FF, D, (bf16_t*)(ws + WS_WDN0), 0, scr, r, lane); continue; } r -= I_DN;
        if (r < I_BIN) { transpose_item(pp->in[10], D, 2 * D, (bf16_t*)(ws + WS_WBIN), 0, scr, r, lane); continue; } r -= I_BIN;
        if (r < I_SQ) { transpose_item(pp->in[16], D, D, (bf16_t*)(ws + WS_WBOUT), 0, scr, r, lane); continue; } r -= I_SQ;
        if (r < I_GU) { transpose_item(pp->in[17] + (size_t)D * FF, D, FF, (bf16_t*)(ws + WS_WGU1), 1, scr, r, lane); continue; } r -= I_GU;
        if (r < I_GU) { transpose_item(pp->in[18] + (size_t)D * FF, D, FF, (bf16_t*)(ws + WS_WGU1), 2, scr, r, lane); continue; } r -= I_GU;
        transpose_item(pp->in[19] + (size_t)FF * D, FF, D, (bf16_t*)(ws + WS_WDN1), 0, scr, r, lane);
    }
}
__device__ __forceinline__ void tail_convert(PP pp, LAS unsigned char* lds, int nwg, int G, int lo, int hi) {
    const int rem = nwg % G;
    if (rem == 0 || (int)blockIdx.x < rem || lo >= hi) return;
    int tid = threadIdx.x; asm volatile("" : "+v"(tid));
    const int wave = __builtin_amdgcn_readfirstlane(tid >> 6), lane = tid & 63;
    convert_items(pp, lds, lo, hi, ((int)blockIdx.x - rem) * NWAVES + wave, (G - rem) * NWAVES, wave, lane);
}

__device__ __forceinline__ void phase0(PP pp, LAS unsigned char* lds, int gw, int NGW, int wave, int lane) {
    unsigned char* ws = pp->ws;
    convert_items(pp, lds, 0, CV_P0, gw, NGW, wave, lane);
    bf16_t* H = (bf16_t*)(ws + WS_H);
    const float* gpre = pp->in[3];
    for (int row = gw; row < M; row += NGW) {
        const float* xr = row < MP ? pp->in[0] + (size_t)row * D : pp->in[1] + (size_t)(row - MP) * D;
        f32x4 xv[4][2]; float ss = 0.f;
#pragma unroll
        for (int j = 0; j < 4; ++j)
#pragma unroll
            for (int h = 0; h < 2; ++h) { xv[j][h] = __builtin_nontemporal_load((const f32x4*)(xr + 512 * j + 8 * lane + 4 * h)); const f32x4 v = xv[j][h]; ss += (v[0] * v[0] + v[1] * v[1]) + (v[2] * v[2] + v[3] * v[3]); }
        const float r = 1.0f / sqrtf(wave_sum(ss) * (1.0f / D) + EPS);
#pragma unroll
        for (int j = 0; j < 4; ++j) { const f32x4 g0 = *(const f32x4*)(gpre + 512 * j + 8 * lane), g1 = *(const f32x4*)(gpre + 512 * j + 8 * lane + 4);
            *(u32x4*)(H + (size_t)row * D + 512 * j + 8 * lane) = pack8(xv[j][0] * r * g0, xv[j][1] * r * g1); }
    }
}

__device__ __forceinline__ void unpack8(u32x4 w, float (&f)[8]) { f[0] = bf_lo(w.x); f[1] = bf_hi(w.x); f[2] = bf_lo(w.y); f[3] = bf_hi(w.y); f[4] = bf_lo(w.z); f[5] = bf_hi(w.z); f[6] = bf_lo(w.w); f[7] = bf_hi(w.w); }
__device__ __forceinline__ void conv_hist(const float* cache, int s0, int hi, int c, float (&p)[8]) {
    if (s0 < MP) {
#pragma unroll
        for (int e = 0; e < 8; ++e) p[e] = 0.f;
    } else { const float* hp = cache + (size_t)(((s0 - MP) >> 4) * 2 + hi) * D + c; const f32x4 a = *(const f32x4*)hp, b = *(const f32x4*)(hp + 4);
        p[0] = a[0]; p[1] = a[1]; p[2] = a[2]; p[3] = a[3]; p[4] = b[0]; p[5] = b[1]; p[6] = b[2]; p[7] = b[3]; }
}
__device__ __forceinline__ void conv_phase(PP pp, int G) {
    unsigned char* ws = pp->ws;
    const bf16_t* GB = (const bf16_t*)(ws + WS_BIG); const bf16_t* CZ = GB + (size_t)M * D; bf16_t* YIN = (bf16_t*)(ws + WS_YIN);
    const float* cw = pp->in[8]; const float* cache = pp->in[2];
    int tid = threadIdx.x; asm volatile("" : "+v"(tid));
    constexpr int R = 17; static_assert(M % R == 0, "row blocks");
    for (int item = blockIdx.x * NTHREADS + tid; item < (M / R) * 256; item += G * NTHREADS) {
        const int cb = item & 255, rb = item >> 8, r0 = rb * R, c = cb * 8;
        float w0[8], w1[8], w2[8], p2[8], p1[8];
#pragma unroll
        for (int e = 0; e < 8; ++e) { w0[e] = cw[c + e]; w1[e] = cw[D + c + e]; w2[e] = cw[2 * D + c + e]; }
        { const int s0 = r0 < MP ? (r0 & ~2047) : MP + ((r0 - MP) & ~15);
          if (r0 - 2 >= s0) unpack8(*(const u32x4*)(CZ + (size_t)(r0 - 2) * D + c), p2); else conv_hist(cache, s0, r0 - s0, c, p2);
          if (r0 - 1 >= s0) unpack8(*(const u32x4*)(CZ + (size_t)(r0 - 1) * D + c), p1); else conv_hist(cache, s0, 1, c, p1); }
#pragma unroll
        for (int i = 0; i < R; ++i) { const int r = r0 + i; const size_t off = (size_t)r * D + c; float cu[8], gb[8], y[8];
            if (i > 0) { const bool start = r < MP ? ((r & 2047) == 0) : (((r - MP) & 15) == 0); if (start) { conv_hist(cache, r, 0, c, p2); conv_hist(cache, r, 1, c, p1); } }
            unpack8(__builtin_nontemporal_load((const u32x4*)(CZ + off)), cu); unpack8(__builtin_nontemporal_load((const u32x4*)(GB + off)), gb);
#pragma unroll
            for (int e = 0; e < 8; ++e) { y[e] = gb[e] * (w0[e] * p2[e] + w1[e] * p1[e] + w2[e] * cu[e]); p2[e] = p1[e]; p1[e] = cu[e]; }
            u32x4 o; o.x = cvt_pk_bf16(y[0], y[1]); o.y = cvt_pk_bf16(y[2], y[3]); o.z = cvt_pk_bf16(y[4], y[5]); o.w = cvt_pk_bf16(y[6], y[7]);
            *(u32x4*)(YIN + off) = o; }
    }
}

__device__ __forceinline__ void resnorm_phase(const float* xp, const float* xs, bf16_t* xb, float* xout, const bf16_t* mb, const float* gpost, const float* gnext, bf16_t* H, int gw, int NGW, int lane, LAS unsigned char* lds) {
    const bool quarter = (NGW == 4 * MS);
    for (int row = gw; row < (quarter ? MP : M); row += NGW) {
        float mf[4][8]; f32x4 xv[4][2]; float ss = 0.f;
        if (xp) { const float* xr = row < MP ? xp + (size_t)row * D : xs + (size_t)(row - MP) * D;
#pragma unroll
            for (int j = 0; j < 4; ++j) { xv[j][0] = *(const f32x4*)(xr + 512 * j + 8 * lane); xv[j][1] = *(const f32x4*)(xr + 512 * j + 8 * lane + 4); }
        } else {
#pragma unroll
            for (int j = 0; j < 4; ++j) { float t[8]; unpack8(__builtin_nontemporal_load((const u32x4*)(xb + (size_t)row * D + 512 * j + 8 * lane)), t); xv[j][0] = (f32x4){t[0], t[1], t[2], t[3]}; xv[j][1] = (f32x4){t[4], t[5], t[6], t[7]}; }
        }
#pragma unroll
        for (int j = 0; j < 4; ++j) { unpack8(__builtin_nontemporal_load((const u32x4*)(mb + (size_t)row * D + 512 * j + 8 * lane)), mf[j]);
#pragma unroll
            for (int e = 0; e < 8; ++e) ss += mf[j][e] * mf[j][e]; }
        const float r = 1.0f / sqrtf(wave_sum(ss) * (1.0f / D) + EPS);
        float ss2 = 0.f;
#pragma unroll
        for (int j = 0; j < 4; ++j) { const f32x4 g0 = *(const f32x4*)(gpost + 512 * j + 8 * lane), g1 = *(const f32x4*)(gpost + 512 * j + 8 * lane + 4);
            const f32x4 m0 = (f32x4){mf[j][0], mf[j][1], mf[j][2], mf[j][3]}, m1 = (f32x4){mf[j][4], mf[j][5], mf[j][6], mf[j][7]};
            xv[j][0] = xv[j][0] + m0 * r * g0; xv[j][1] = xv[j][1] + m1 * r * g1;
#pragma unroll
            for (int h = 0; h < 2; ++h) { const f32x4 v = xv[j][h]; ss2 += (v[0] * v[0] + v[1] * v[1]) + (v[2] * v[2] + v[3] * v[3]); }
            if (gnext) *(u32x4*)(xb + (size_t)row * D + 512 * j + 8 * lane) = pack8(xv[j][0], xv[j][1]);
            else { *(f32x4*)(xout + (size_t)row * D + 512 * j + 8 * lane) = xv[j][0]; *(f32x4*)(xout + (size_t)row * D + 512 * j + 8 * lane + 4) = xv[j][1]; } }
        if (gnext) {
            const float r2 = 1.0f / sqrtf(wave_sum(ss2) * (1.0f / D) + EPS);
#pragma unroll
            for (int j = 0; j < 4; ++j) { const f32x4 g0 = *(const f32x4*)(gnext + 512 * j + 8 * lane), g1 = *(const f32x4*)(gnext + 512 * j + 8 * lane + 4);
                *(u32x4*)(H + (size_t)row * D + 512 * j + 8 * lane) = pack8(xv[j][0] * r2 * g0, xv[j][1] * r2 * g1); }
        }
    }
    if (quarter) {
        const int wave = (gw & 7), q = wave & 3, row = MP + (gw >> 2); const size_t off = (size_t)row * D + 512 * q + 8 * lane;
        LAS float* red = (LAS float*)lds;
        float t[8], mf[8];
        if (xp) { const float* xr = xs + (size_t)(row - MP) * D + 512 * q + 8 * lane; const f32x4 a = *(const f32x4*)xr, b = *(const f32x4*)(xr + 4); t[0] = a[0]; t[1] = a[1]; t[2] = a[2]; t[3] = a[3]; t[4] = b[0]; t[5] = b[1]; t[6] = b[2]; t[7] = b[3]; }
        else unpack8(__builtin_nontemporal_load((const u32x4*)(xb + off)), t);
        unpack8(__builtin_nontemporal_load((const u32x4*)(mb + off)), mf);
        float ss = 0.f;
#pragma unroll
        for (int e = 0; e < 8; ++e) ss += mf[e] * mf[e];
        ss = wave_sum(ss);
        __syncthreads();
        if (lane == 0) red[wave] = ss;
        __syncthreads();
        const int w4 = wave & 4;
        const float r = 1.0f / sqrtf(((red[w4] + red[w4 + 1]) + (red[w4 + 2] + red[w4 + 3])) * (1.0f / D) + EPS);
        const f32x4 g0 = *(const f32x4*)(gpost + 512 * q + 8 * lane), g1 = *(const f32x4*)(gpost + 512 * q + 8 * lane + 4);
        f32x4 x0 = (f32x4){t[0], t[1], t[2], t[3]} + (f32x4){mf[0], mf[1], mf[2], mf[3]} * r * g0, x1 = (f32x4){t[4], t[5], t[6], t[7]} + (f32x4){mf[4], mf[5], mf[6], mf[7]} * r * g1;
        if (gnext) {
            *(u32x4*)(xb + off) = pack8(x0, x1);
            float ss2 = (x0[0] * x0[0] + x0[1] * x0[1]) + (x0[2] * x0[2] + x0[3] * x0[3]) + (x1[0] * x1[0] + x1[1] * x1[1]) + (x1[2] * x1[2] + x1[3] * x1[3]);
            ss2 = wave_sum(ss2);
            if (lane == 0) red[8 + wave] = ss2;
            __syncthreads();
            const float r2 = 1.0f / sqrtf(((red[8 + w4] + red[9 + w4]) + (red[10 + w4] + red[11 + w4])) * (1.0f / D) + EPS);
            const f32x4 n0 = *(const f32x4*)(gnext + 512 * q + 8 * lane), n1 = *(const f32x4*)(gnext + 512 * q + 8 * lane + 4);
            *(u32x4*)(H + off) = pack8(x0 * r2 * n0, x1 * r2 * n1);
        } else { *(f32x4*)(xout + off) = x0; *(f32x4*)(xout + off + 4) = x1; }
    }
}

__device__ __forceinline__ void sgu_phase(PP pp, LAS unsigned char* lds, int G) {
    unsigned char* ws = pp->ws;
    LAS bf16_t* Aw = (LAS bf16_t*)lds;
    LAS bf16_t* Vt = (LAS bf16_t*)(lds + 34816);
    LAS float* St = (LAS float*)(lds + 69632);
    const bf16_t* ZZ = (const bf16_t*)(ws + WS_BIG); const float* stats = (const float*)(ws + WS_STATS); bf16_t* YIN = (bf16_t*)(ws + WS_YIN);
    const float* ln_g = pp->in[12]; const float* ln_b = pp->in[13]; const float* w_s = pp->in[14]; const float* b_s = pp->in[15];
    float* st_sgu = pp->out + O_SGU;
    int tid = threadIdx.x; asm volatile("" : "+v"(tid));
    const int wid = tid >> 6, lane = tid & 63, wr = wid >> 2, wc = wid & 3, fr = lane & 15, fq = lane >> 4;
    for (int unit = blockIdx.x; unit < (M / 128) * 16; unit += G) {
        const int rt = unit >> 4, g = unit & 15, r0 = rt * 128, c0 = g * 128; const bool sample = rt >= (MP / 128);
        __syncthreads();
        if (tid < 128) { const f32x4* sp = (const f32x4*)(stats + (size_t)(r0 + tid) * 64); float s = 0.f, ss = 0.f;
#pragma unroll
            for (int q = 0; q < 16; ++q) { const f32x4 v = sp[q]; s += v[0] + v[2]; ss += v[1] + v[3]; }
            const float mean = s * (1.0f / 2048.0f), var = ss * (1.0f / 2048.0f) - mean * mean;
            St[2 * tid] = mean; St[2 * tid + 1] = 1.0f / sqrtf(fmaxf(var, 0.f) + EPS); }
        const float* wg = w_s + (size_t)g * 128 * 128;
#pragma unroll
        for (int q = 0; q < 8; ++q) { const int idx = q * NTHREADS + tid, i = idx >> 5, j4 = (idx & 31) * 4;
            int lim, so;
            if (!sample) { so = i * 128 + j4; lim = i - j4; }
            else { const int ii = i & 15, jj = j4 & 15; so = ii * 128 + jj; lim = ((i >> 4) == (j4 >> 4)) ? ii - jj : -1; }
            f32x4 w = *(const f32x4*)(wg + so);
#pragma unroll
            for (int e = 0; e < 4; ++e) w[e] = __uint_as_float(__float_as_uint(w[e]) & ~(unsigned)((lim - e) >> 31));
            u32x2 o; o.x = cvt_pk_bf16(w[0], w[1]); o.y = cvt_pk_bf16(w[2], w[3]);
            *(LAS u32x2*)(Aw + i * 136 + j4) = o; }
        __syncthreads();
        { const int ch = lane & 15, c = c0 + 8 * ch;
            const f32x4 lg0 = *(const f32x4*)(ln_g + c), lg1 = *(const f32x4*)(ln_g + c + 4), lb0 = *(const f32x4*)(ln_b + c), lb1 = *(const f32x4*)(ln_b + c + 4);
            u32x4 raw[4];
#pragma unroll
            for (int it = 0; it < 4; ++it) raw[it] = *(const u32x4*)(ZZ + (size_t)(r0 + wid * 16 + it * 4 + (lane >> 4)) * 4096 + 2048 + c);
#pragma unroll
            for (int it = 0; it < 4; ++it) { const int j = wid * 16 + it * 4 + (lane >> 4), r = r0 + j; const float mean = St[2 * j], rstd = St[2 * j + 1]; float v[8];
                unpack8(raw[it], v);
#pragma unroll
                for (int e = 0; e < 8; ++e) v[e] = (v[e] - mean) * rstd * (e < 4 ? lg0[e & 3] : lg1[e & 3]) + (e < 4 ? lb0[e & 3] : lb1[e & 3]);
                if (sample) { float* sp = st_sgu + (size_t)(r - MP) * 2048 + c; *(f32x4*)sp = (f32x4){v[0], v[1], v[2], v[3]}; *(f32x4*)(sp + 4) = (f32x4){v[4], v[5], v[6], v[7]}; }
                const int jo = (((j >> 3) ^ ch) << 3) + (j & 7);
#pragma unroll
                for (int e = 0; e < 8; e += 2) { const unsigned pk = cvt_pk_bf16(v[e], v[e + 1]); Vt[(8 * ch + e) * 136 + jo] = (bf16_t)(pk & 0xffffu); Vt[(8 * ch + e + 1) * 136 + jo] = (bf16_t)(pk >> 16); } }
        }
        __syncthreads();
        f32x4 acc[4][2];
#pragma unroll
        for (int m = 0; m < 4; ++m)
#pragma unroll
            for (int n = 0; n < 2; ++n) acc[m][n] = (f32x4){0.f, 0.f, 0.f, 0.f};
#pragma unroll
        for (int k = 0; k < 4; ++k) { bf16x8 Af[4], Bf[2];
#pragma unroll
            for (int m = 0; m < 4; ++m) Af[m] = *(const LAS bf16x8*)(Aw + (64 * wr + 16 * m + fr) * 136 + 32 * k + 8 * fq);
#pragma unroll
            for (int n = 0; n < 2; ++n) { const int d = 32 * wc + 8 * (fr >> 2) + 4 * n + (fr & 3); Bf[n] = *(const LAS bf16x8*)(Vt + d * 136 + (((4 * k + fq) ^ ((d >> 3) & 15)) << 3)); }
#pragma unroll
            for (int m = 0; m < 4; ++m)
#pragma unroll
                for (int n = 0; n < 2; ++n) acc[m][n] = __builtin_amdgcn_mfma_f32_16x16x32_bf16(Bf[n], Af[m], acc[m][n], 0, 0, 0); }
#pragma unroll
        for (int m = 0; m < 4; ++m) { const int i = 64 * wr + 16 * m + fr, r = r0 + i; const float bias = b_s[g * 128 + (sample ? (i & 15) : i)];
            const int d = c0 + 32 * wc + 8 * fq; float u[8]; unpack8(*(const u32x4*)(ZZ + (size_t)r * 4096 + d), u);
            const f32x4 o0 = (f32x4){u[0], u[1], u[2], u[3]} * (acc[m][0] + bias), o1 = (f32x4){u[4], u[5], u[6], u[7]} * (acc[m][1] + bias);
            *(u32x4*)(YIN + (size_t)r * D + d) = pack8(o0, o1); }
    }
    __syncthreads();
}

#define XB_TMO      128
#define XB_XCNT(j)  (256  + 64 * (j))
#define XB_XSUB(j)  (1280 + 64 * (j))
#define XB_XGEN(j)  (2304 + 64 * (j))
#define XB_TOP      3328
#define XB_TOPGEN   3392
#define XCD_BAR_WORDS 3456
#define XB_SPIN_CAP (1u << 18)
__device__ __forceinline__ unsigned xb_ld(unsigned* p)              { return __hip_atomic_load(p, __ATOMIC_RELAXED, __HIP_MEMORY_SCOPE_AGENT); }
__device__ __forceinline__ unsigned xb_add(unsigned* p, unsigned v) { return __hip_atomic_fetch_add(p, v, __ATOMIC_RELAXED, __HIP_MEMORY_SCOPE_AGENT); }
__device__ __forceinline__ unsigned xb_xcc_id() { return (unsigned)__builtin_amdgcn_s_getreg((3 << 11) | 20) & 0xFu; }
#define XB_SPIN(cond, bar) do { unsigned _sp = 0; while (cond) { __builtin_amdgcn_s_sleep(1); \
    if ((++_sp & 255u) == 0u) { if (xb_ld(&(bar)[XB_TMO])) break; if (_sp > XB_SPIN_CAP) { atomicAdd(&(bar)[XB_TMO], 1u); break; } } } } while (0)
__device__ __forceinline__ void xcd_barrier_complete(unsigned* bar, unsigned x, unsigned& nloc, unsigned& nx) {
    const unsigned G = gridDim.x * gridDim.y * gridDim.z;
    unsigned sum, cnt, mine, sp = 0u;
    for (;;) {
        sum = 0u; cnt = 0u; mine = 0u;
#pragma unroll
        for (unsigned j = 0; j < 16; ++j) { const unsigned c = xb_ld(&bar[XB_XCNT(j)]); sum += c; cnt += (c > 0u) ? 1u : 0u; mine = (j == x) ? c : mine; }
        if (sum == G) break;
        __builtin_amdgcn_s_sleep(1);
        if ((++sp & 255u) == 0u) { if (xb_ld(&bar[XB_TMO])) break; if (sp > XB_SPIN_CAP) { atomicAdd(&bar[XB_TMO], 1u); break; } }
    }
    nloc = mine > 0u ? mine : 1u; nx = cnt > 0u ? cnt : 1u;
}
__device__ __forceinline__ void xcd_barrier(unsigned* bar, volatile LAS unsigned* st) {
    asm volatile("s_waitcnt vmcnt(0)" ::: "memory");
    __syncthreads();
    if (threadIdx.x == 0) {
        __builtin_amdgcn_s_waitcnt(0);
        const unsigned x = xb_xcc_id();
        unsigned nloc = st[0], nx = st[1];
        if (nloc == 0u) { xcd_barrier_complete(bar, x, nloc, nx); st[0] = nloc; st[1] = nx; }
        const unsigned old = xb_add(&bar[XB_XSUB(x)], 1u);
        const unsigned gen = old / nloc;
        if (old + 1u == (gen + 1u) * nloc) {
            __builtin_amdgcn_fence(__ATOMIC_RELEASE, "agent");
            asm volatile("s_waitcnt vmcnt(0)" ::: "memory");
            const unsigned og = xb_add(&bar[XB_TOP], 1u);
            const unsigned tg = og / nx;
            if (og + 1u == (tg + 1u) * nx) xb_add(&bar[XB_TOPGEN], 1u);
            else XB_SPIN(xb_ld(&bar[XB_TOPGEN]) == tg, bar);
            __builtin_amdgcn_fence(__ATOMIC_ACQUIRE, "agent");
            xb_add(&bar[XB_XGEN(x)], 1u);
            asm volatile("s_waitcnt vmcnt(0)" ::: "memory");
        } else {
            XB_SPIN(xb_ld(&bar[XB_XGEN(x)]) == gen, bar);
            __builtin_amdgcn_fence(__ATOMIC_ACQUIRE, "agent");
            asm volatile("s_waitcnt vmcnt(0)" ::: "memory");
        }
    }
    __syncthreads();
}

__global__ void __launch_bounds__(NTHREADS, 2) mega(Params p_arg) {
    extern __shared__ __attribute__((aligned(16))) unsigned char lds_raw[];
    LAS unsigned char* lds = (LAS unsigned char*)lds_raw;
    cg::grid_group grid = cg::this_grid();
    PP pp = (PP)__builtin_amdgcn_kernarg_segment_ptr();
    const int G = gridDim.x, NGW = G * NWAVES;
#define LANE_IDS() int tid = threadIdx.x; asm volatile("" : "+v"(tid)); const int wave = __builtin_amdgcn_readfirstlane(tid >> 6), lane = tid & 63, gw = blockIdx.x * NWAVES + wave

    if (threadIdx.x < 2) ((volatile LAS unsigned*)(lds + LDS_STAGE))[threadIdx.x] = 0u;
    if (threadIdx.x == 0) (void)xb_add(&((unsigned*)(pp->ws + WS_BAR))[XB_XCNT(xb_xcc_id())], 1u);
    if (G > 0x40000000) grid.sync();
    { LANE_IDS(); phase0(pp, lds, gw, NGW, wave, lane); }
    GSYNC();

#pragma nounroll
    for (int layer = 0; layer < 2; ++layer) {
        FRESH(pp);
        if (layer == 0) {
            { unsigned char* ws = pp->ws; float* out = pp->out; bf16_t* BIG = (bf16_t*)(ws + WS_BIG);
              pg8::Gemm g{(const bf16_t*)(ws + WS_H), (const bf16_t*)(ws + WS_WAIN), M, 3 * D, D}; pg8::StaticOrder S; S.init(M, 3 * D, G, (int)blockIdx.x);
              EpiCZ E{BIG, BIG + (size_t)M * D, out + O_SCP, out + O_SCS};
              pg8::gemm_phase<EpiCZ>(lds, g, S, E);
              tail_convert(pp, lds, S.nwg, G, CV_P0, CV_T1); }
            GSYNC();
            FRESH(pp);
            conv_phase(pp, G);
            GSYNC();
        } else {
            { unsigned char* ws = pp->ws;
              pg8::Gemm g{(const bf16_t*)(ws + WS_H), (const bf16_t*)(ws + WS_WBIN), M, 2 * D, D}; pg8::StaticOrder S; S.init(M, 2 * D, G, (int)blockIdx.x);
              EpiGelu E{(bf16_t*)(ws + WS_BIG), pp->in[11], (float*)(ws + WS_STATS)};
              pg8::gemm_phase<EpiGelu>(lds, g, S, E);
              tail_convert(pp, lds, S.nwg, G, CV_T3, CV_T8); }
            GSYNC();
            FRESH(pp);
            sgu_phase(pp, lds, G);
            GSYNC();
        }
#pragma nounroll
        for (int sub = 0; sub < 2; ++sub) {
            if (sub == 1) {
                FRESH(pp);
                unsigned char* ws = pp->ws;
                pg8::Gemm g{(const bf16_t*)(ws + WS_H), (const bf16_t*)(ws + (layer ? WS_WGU1 : WS_WGU0)), M, 2 * FF, D}; pg8::StaticOrder S; S.init(M, 2 * FF, G, (int)blockIdx.x);
                EpiGU E{(bf16_t*)(ws + WS_BIG)};
                pg8::gemm_phase<EpiGU>(lds, g, S, E);
                GSYNC();
            }
            { FRESH(pp);
              unsigned char* ws = pp->ws;
              const bf16_t* A = (const bf16_t*)(ws + (sub ? WS_BIG : WS_YIN)); const int K = sub ? FF : D;
              const bf16_t* Bt = (const bf16_t*)(ws + (sub ? (layer ? WS_WDN1 : WS_WDN0) : (layer ? WS_WBOUT : WS_WAOUT)));
              pg8::Gemm g{A, Bt, M, D, K}; pg8::StaticOrder S; S.init(M, D, G, (int)blockIdx.x);
              EpiPlain E{(bf16_t*)(ws + WS_MB), D};
              pg8::gemm_phase<EpiPlain>(lds, g, S, E);
              if (sub == 0) tail_convert(pp, lds, S.nwg, G, layer ? CV_T8 : CV_T1, layer ? CV_T10 : CV_T3); }
            GSYNC();
            { FRESH(pp); LANE_IDS();
              unsigned char* ws = pp->ws;
              const bool first = (layer == 0 && sub == 0), lastp = (layer == 1 && sub == 1);
              const float* xp = first ? pp->in[0] : nullptr; const float* xs = first ? pp->in[1] : nullptr;
              const float* gpost = (sub ? pp->in[6] : pp->in[4]) + layer * D;
              const float* gnext = lastp ? nullptr : (sub ? pp->in[3] + D : pp->in[5] + layer * D);
              resnorm_phase(xp, xs, (bf16_t*)(ws + WS_XB), pp->out + O_Y, (const bf16_t*)(ws + WS_MB), gpost, gnext, (bf16_t*)(ws + WS_H), gw, NGW, lane, lds); }
            if (!(layer == 1 && sub == 1)) GSYNC();
        }
    }
}

extern "C" void kernel_launch(void* const* d_in, const int* in_sizes, int n_in, void* d_out, int out_size, void* d_ws, size_t ws_size, hipStream_t stream) {
    static int grid = 0;
    if (grid == 0) {
        if (ws_size < WS_END) { fprintf(stderr, "kernel_launch: workspace too small: %zu < %zu\n", ws_size, (size_t)WS_END); grid = -1; return; }
        int dev = 0, cus = 0, per_cu = 0;
        (void)hipGetDevice(&dev);
        (void)hipDeviceGetAttribute(&cus, hipDeviceAttributeMultiprocessorCount, dev);
        if (hipFuncSetAttribute((const void*)mega, hipFuncAttributeMaxDynamicSharedMemorySize, LDS_BYTES) != hipSuccess) fprintf(stderr, "kernel_launch: hipFuncSetAttribute failed\n");
        if (hipOccupancyMaxActiveBlocksPerMultiprocessor(&per_cu, (const void*)mega, NTHREADS, LDS_BYTES) != hipSuccess || per_cu < 1) per_cu = 1;
        (void)hipGetLastError();
        grid = cus * per_cu;
    }
    if (grid < 0) return;
    if (hipMemsetAsync((char*)d_ws + WS_BAR, 0, XCD_BAR_WORDS * 4, stream) != hipSuccess) fprintf(stderr, "kernel_launch: memset of the barrier words failed\n");
    Params p{};
    for (int i = 0; i < 20; ++i) p.in[i] = (const float*)d_in[i];
    p.out = (float*)d_out; p.ws = (unsigned char*)d_ws;
    void* args[] = {&p};
    hipError_t e = hipLaunchCooperativeKernel((const void*)mega, dim3(grid), dim3(NTHREADS), args, LDS_BYTES, stream);
    if (e != hipSuccess) fprintf(stderr, "cooperative launch failed: %s (grid %d)\n", hipGetErrorString(e), grid);
}
```

```cpp
#include <hip/hip_runtime.h>
#include <hip/hip_cooperative_groups.h>
#include <cstdio>
namespace cg = cooperative_groups;

#define LAS __attribute__((address_space(3)))
typedef unsigned short bf16_t;
typedef short bf16x8 __attribute__((ext_vector_type(8)));
typedef float f32x4 __attribute__((ext_vector_type(4)));
typedef float f32x2 __attribute__((ext_vector_type(2)));
typedef unsigned u32x4 __attribute__((ext_vector_type(4)));
typedef unsigned u32x2 __attribute__((ext_vector_type(2)));

#define REP_P0 1
#define REP_SYNC 1
#define REP_GEMM 1
#define REP_MIX 1
#define REP_RES 1
#define GSYNC() do { for (int _r = 0; _r < REP_SYNC; ++_r) xcd_barrier((unsigned*)(pp->ws + WS_BAR), (volatile LAS unsigned*)(lds + LDS_STAGE)); } while (0)

constexpr int D = 2048, MP = 8192, MS = 512, M = MP + MS, FF = 5632;
constexpr float EPS = 1e-6f;
constexpr int NTHREADS = 512, NWAVES = 8;
constexpr int LDS_STAGE = 131072;
constexpr int LDS_BYTES = LDS_STAGE + 16;

constexpr size_t WS_WAIN = 0;
constexpr size_t WS_WAOUT = WS_WAIN + (size_t)6144 * 2048 * 2;
constexpr size_t WS_WBIN = WS_WAOUT + (size_t)2048 * 2048 * 2;
constexpr size_t WS_WBOUT = WS_WBIN + (size_t)4096 * 2048 * 2;
constexpr size_t WS_WGU0 = WS_WBOUT + (size_t)2048 * 2048 * 2;
constexpr size_t WS_WGU1 = WS_WGU0 + (size_t)11264 * 2048 * 2;
constexpr size_t WS_WDN0 = WS_WGU1 + (size_t)11264 * 2048 * 2;
constexpr size_t WS_WDN1 = WS_WDN0 + (size_t)2048 * 5632 * 2;
constexpr size_t WS_H = WS_WDN1 + (size_t)2048 * 5632 * 2;
constexpr size_t WS_BIG = WS_H + (size_t)M * 2048 * 2;
constexpr size_t WS_YIN = WS_BIG + (size_t)M * 5632 * 2;
constexpr size_t WS_MB = WS_YIN + (size_t)M * 2048 * 2;
constexpr size_t WS_STATS = WS_MB + (size_t)M * 2048 * 2;
constexpr size_t WS_XB = WS_STATS + (size_t)M * 64 * 4;
constexpr size_t WS_PART = WS_XB + (size_t)M * 2048 * 2;
constexpr size_t WS_BAR = WS_PART + (size_t)4 * MS * 2048 * 2;
constexpr size_t WS_END = WS_BAR + 3456 * 4;

constexpr size_t O_Y = 0;
constexpr size_t O_SCP = (size_t)M * D;
constexpr size_t O_SCS = O_SCP + 4 * 2 * 2048;
constexpr size_t O_SGU = O_SCS + 32 * 2 * 2048;

struct Params { const float* in[20]; float* out; unsigned char* ws; };
typedef const __attribute__((address_space(4))) Params* PP;
#define FRESH(pp) asm volatile("" : "+s"(pp) :: "memory")

__device__ __forceinline__ unsigned cvt_pk_bf16(float lo, float hi) { unsigned r; asm("v_cvt_pk_bf16_f32 %0, %1, %2" : "=v"(r) : "v"(lo), "v"(hi)); return r; }
__device__ __forceinline__ float bf_lo(unsigned w) { return __uint_as_float(w << 16); }
__device__ __forceinline__ float bf_hi(unsigned w) { return __uint_as_float(w & 0xffff0000u); }
__device__ __forceinline__ float wave_sum(float v) {
#pragma unroll
    for (int o = 1; o < 64; o <<= 1) v += __shfl_xor(v, o);
    return v;
}
__device__ __forceinline__ f32x2 gelu_pk(f32x2 v) {
    const f32x2 av = __builtin_elementwise_abs(v), d = av * 0.2316418882f + 1.0f;
    f32x2 t; t.x = __builtin_amdgcn_rcpf(d.x); t.y = __builtin_amdgcn_rcpf(d.y);
    f32x2 q = t * 0.5307027145f + (-0.7265760135f); q = q * t + 0.7107068705f; q = q * t + (-0.142248368f); q = q * t + 0.127414796f; q = q * t;
    const f32x2 s = (v * v) * (-0.72134752044f);
    f32x2 e; e.x = __builtin_amdgcn_exp2f(s.x); e.y = __builtin_amdgcn_exp2f(s.y);
    const f32x2 h = 0.5f - q * e;
    return v * 0.5f + av * h;
}
__device__ __forceinline__ f32x4 gelu4(f32x4 v) { f32x2 a = gelu_pk((f32x2){v[0], v[1]}), b = gelu_pk((f32x2){v[2], v[3]}); return (f32x4){a.x, a.y, b.x, b.y}; }
__device__ __forceinline__ float silu1(float x) { return x * __builtin_amdgcn_rcpf(1.0f + __builtin_amdgcn_exp2f(-1.4426950408889634f * x)); }
__device__ __forceinline__ f32x4 silu_mul4(f32x4 g, f32x4 u) {
    const f32x4 t = g * (-1.4426950408889634f);
    f32x4 e; e[0] = __builtin_amdgcn_exp2f(t[0]); e[1] = __builtin_amdgcn_exp2f(t[1]); e[2] = __builtin_amdgcn_exp2f(t[2]); e[3] = __builtin_amdgcn_exp2f(t[3]);
    const f32x4 d = e + 1.0f, gu = g * u;
    f32x4 r; r[0] = __builtin_amdgcn_rcpf(d[0]); r[1] = __builtin_amdgcn_rcpf(d[1]); r[2] = __builtin_amdgcn_rcpf(d[2]); r[3] = __builtin_amdgcn_rcpf(d[3]);
    return gu * r;
}

namespace pg8 {
constexpr int BM = 256, BK = 64, HALF = 128, HTB = HALF * BK * 2, NXCD = 8, WGM = 8;
__device__ __forceinline__ int swz_g(int r) { return ((r >> 1) & 3) ^ (((r >> 3) & 1) << 2); }
__device__ __forceinline__ int lds_byte(int r, int c) { return (r >> 3) * 1024 + (r & 7) * 128 + (((c >> 3) ^ swz_g(r)) << 4) + (c & 7) * 2; }
__device__ __forceinline__ void stage_rc(int b, int& R, int& C) { const int s = b >> 10, sb = b & 1023, rs = sb >> 7, cs = (sb & 127) >> 4; R = s * 8 + rs; C = (cs ^ swz_g(R)) << 3; }
__device__ __forceinline__ int perm32(int rho) { const int n = rho >> 4, i = rho & 15; return 8 * (i >> 2) + 4 * n + (i & 3); }

struct Unit { int pm, pn; };
struct Gemm { const bf16_t* A; const bf16_t* Bt; int M, N, K, ldk, nn; };
struct StaticOrder {
    int nM, nN, nwg, G, c;
    __device__ void init(int M_, int N_, int G_, int c_) { nM = M_ / BM; nN = N_ / BM; nwg = nM * nN; G = G_; c = c_; }
    __device__ bool next(int i, Unit& u) const {
        const long L = (long)i * G + c; if (L >= nwg) return false;
        int wgid = (int)L; { const int q = nwg / NXCD, r = nwg % NXCD, xcd = wgid % NXCD, off = wgid / NXCD; wgid = (xcd < r ? xcd * (q + 1) : r * (q + 1) + (xcd - r) * q) + off; }
        const int nig = WGM * nN, gid = wgid / nig, fm = gid * WGM, gsz = (nM - fm) < WGM ? (nM - fm) : WGM;
        u.pm = fm + ((wgid % nig) % gsz); u.pn = (wgid % nig) / gsz; return true;
    }
};

template <class Epi>
__device__ __forceinline__ void gemm_phase(LAS unsigned char* lds, const Gemm g, const StaticOrder& S, const Epi& E) {
    int tid = threadIdx.x; asm volatile("" : "+v"(tid));
    const int wid = __builtin_amdgcn_readfirstlane(tid >> 6), lane = tid & 63, wr = wid >> 2, wc = wid & 3, fr = lane & 15, fq = lane >> 4;
    const int K = g.K, nt = K / BK;
    unsigned voffA[2], voffB[2];
#pragma unroll
    for (int i = 0; i < 2; ++i) { int R, C; stage_rc(tid * 16 + i * 8192, R, C); const int Rb = (R & ~31) + perm32(R & 31);
        voffA[i] = (unsigned)(R * g.ldk + C) * 2u; voffB[i] = (unsigned)(Rb * g.ldk + C) * 2u; }
    const size_t kstep = (size_t)(BK * 2);
    const size_t hstep = (size_t)HALF * g.ldk * 2;
    const size_t tstep = 2 * hstep;
    const unsigned ldsw = (unsigned)wid * 1024u;
    const int aoff0 = lds_byte(wr * 64 + fr, fq * 8), aoff1 = lds_byte(wr * 64 + fr, 32 + fq * 8), boff0 = lds_byte(wc * 32 + fr, fq * 8), boff1 = lds_byte(wc * 32 + fr, 32 + fq * 8);
#define PG8_SA(b, h) (((b) * 2 + (h)) * HTB)
#define PG8_SB(b, h) ((4 + (b) * 2 + (h)) * HTB)
#define PG8_STAGE(bufoff, gbase, voff) do { _Pragma("unroll") for (int _i = 0; _i < 2; ++_i) \
        __builtin_amdgcn_global_load_lds((const unsigned*)((const char*)(gbase) + (voff)[_i]), (LAS unsigned*)(lds + (bufoff) + ldsw + _i * 8192), 16, 0, 0); } while (0)
#define PG8_LDA(dst, b, h) do { _Pragma("unroll") for (int m = 0; m < 4; ++m) _Pragma("unroll") for (int k = 0; k < 2; ++k) dst[m][k] = *(const LAS bf16x8*)(lds + PG8_SA(b, h) + (k ? aoff1 : aoff0) + m * 2048); } while (0)
#define PG8_LDB(dst, b, h) do { _Pragma("unroll") for (int n = 0; n < 2; ++n) _Pragma("unroll") for (int k = 0; k < 2; ++k) dst[n][k] = *(const LAS bf16x8*)(lds + PG8_SB(b, h) + (k ? boff1 : boff0) + n * 2048); } while (0)
#define PG8_MMA(ai, bj, At, Bt) do { __builtin_amdgcn_s_setprio(1); _Pragma("unroll") for (int m = 0; m < 4; ++m) _Pragma("unroll") for (int n = 0; n < 2; ++n) _Pragma("unroll") for (int k = 0; k < 2; ++k) \
        acc[ai][bj][m][n] = __builtin_amdgcn_mfma_f32_16x16x32_bf16(Bt[n][k], At[m][k], acc[ai][bj][m][n], 0, 0, 0); __builtin_amdgcn_s_setprio(0); } while (0)
#define PG8_WAIT_V(n) asm volatile("s_waitcnt vmcnt(" #n ")" ::: "memory")
#define PG8_WAIT_L(n) asm volatile("s_waitcnt lgkmcnt(" #n ")" ::: "memory")
#define PG8_BAR __builtin_amdgcn_s_barrier()
#define PG8_SCHED __builtin_amdgcn_sched_barrier(0)
    Unit cur, nxt; int ui = 0;
    if (!S.next(0, cur)) return;
    f32x4 acc[2][2][4][2];
#pragma unroll
    for (int a = 0; a < 2; ++a)
#pragma unroll
        for (int b = 0; b < 2; ++b)
#pragma unroll
            for (int m = 0; m < 4; ++m)
#pragma unroll
                for (int n = 0; n < 2; ++n) acc[a][b][m][n] = (f32x4){0.f, 0.f, 0.f, 0.f};
    bf16x8 At[4][2], B0[2][2], B1[2][2];
    const size_t pstep = (size_t)K * 2;
    const char* cA = (const char*)g.A + (size_t)cur.pm * tstep + (size_t)(cur.pn / g.nn) * pstep; const char* cB = (const char*)g.Bt + (size_t)(cur.pn % g.nn) * tstep + (size_t)(cur.pn / g.nn) * pstep;
    PG8_STAGE(PG8_SB(0, 0), cB, voffB); PG8_STAGE(PG8_SA(0, 0), cA, voffA); PG8_STAGE(PG8_SB(0, 1), cB + hstep, voffB); PG8_STAGE(PG8_SA(0, 1), cA + hstep, voffA);
    if (wr == 1) PG8_BAR;
    PG8_WAIT_V(4); PG8_BAR;
    PG8_STAGE(PG8_SB(1, 0), cB + kstep, voffB); PG8_STAGE(PG8_SA(1, 0), cA + kstep, voffA); PG8_STAGE(PG8_SB(1, 1), cB + hstep + kstep, voffB);
    PG8_WAIT_V(6); PG8_BAR;
    for (;;) {
        const bool has_next = S.next(ui + 1, nxt);
        const char* nA = has_next ? (const char*)g.A + (size_t)nxt.pm * tstep + (size_t)(nxt.pn / g.nn) * pstep : cA; const char* nB = has_next ? (const char*)g.Bt + (size_t)(nxt.pn % g.nn) * tstep + (size_t)(nxt.pn / g.nn) * pstep : cB;
        asm volatile(".p2align 8");
        for (int t = 0; t < nt; t += 2) {
            const bool last = (t == nt - 2);
            const char* a1 = cA + (size_t)(t + 1) * kstep;
            const char* a2 = last ? nA : cA + (size_t)(t + 2) * kstep; const char* b2 = last ? nB : cB + (size_t)(t + 2) * kstep;
            const char* a3 = a2 + kstep; const char* b3 = b2 + kstep;
            PG8_LDB(B0, 0, 0); PG8_SCHED; PG8_LDA(At, 0, 0); PG8_STAGE(PG8_SA(1, 1), a1 + hstep, voffA);
            PG8_WAIT_L(8); PG8_BAR; PG8_WAIT_L(0); PG8_MMA(0, 0, At, B0); PG8_BAR; PG8_SCHED;
            PG8_LDB(B1, 0, 1); PG8_STAGE(PG8_SB(0, 0), b2, voffB);
            PG8_BAR; PG8_WAIT_L(0); PG8_MMA(0, 1, At, B1); PG8_BAR;
            PG8_LDA(At, 0, 1); PG8_STAGE(PG8_SA(0, 0), a2, voffA);
            PG8_BAR; PG8_WAIT_L(0); PG8_MMA(1, 0, At, B0); PG8_BAR; PG8_SCHED;
            PG8_STAGE(PG8_SB(0, 1), b2 + hstep, voffB);
            PG8_WAIT_V(6); PG8_BAR; PG8_MMA(1, 1, At, B1); PG8_BAR;
            PG8_LDB(B0, 1, 0); PG8_SCHED; PG8_LDA(At, 1, 0); PG8_STAGE(PG8_SA(0, 1), a2 + hstep, voffA);
            PG8_WAIT_L(8); PG8_BAR; PG8_WAIT_L(0); PG8_MMA(0, 0, At, B0); PG8_BAR; PG8_SCHED;
            PG8_LDB(B1, 1, 1); PG8_STAGE(PG8_SB(1, 0), b3, voffB);
            PG8_BAR; PG8_WAIT_L(0); PG8_MMA(0, 1, At, B1); PG8_BAR;
            PG8_LDA(At, 1, 1); PG8_STAGE(PG8_SA(1, 0), a3, voffA);
            PG8_BAR; PG8_WAIT_L(0); PG8_MMA(1, 0, At, B0); PG8_BAR; PG8_SCHED;
            PG8_STAGE(PG8_SB(1, 1), b3 + hstep, voffB);
            PG8_WAIT_V(6); PG8_BAR; PG8_MMA(1, 1, At, B1); PG8_BAR;
        }
        E(acc, cur, wr, wc, fr, fq);
        if (!has_next) break;
#pragma unroll
        for (int a = 0; a < 2; ++a)
#pragma unroll
            for (int b = 0; b < 2; ++b)
#pragma unroll
                for (int m = 0; m < 4; ++m)
#pragma unroll
                    for (int n = 0; n < 2; ++n) acc[a][b][m][n] = (f32x4){0.f, 0.f, 0.f, 0.f};
        cur = nxt; cA = nA; cB = nB; ++ui;
    }
    PG8_WAIT_V(0);
    if (wr == 0) PG8_BAR;
    PG8_BAR;
#undef PG8_SA
#undef PG8_SB
#undef PG8_STAGE
#undef PG8_LDA
#undef PG8_LDB
#undef PG8_MMA
#undef PG8_WAIT_V
#undef PG8_WAIT_L
#undef PG8_BAR
#undef PG8_SCHED
}
}
using pg8::Unit;

__device__ __forceinline__ u32x4 pack8(f32x4 v0, f32x4 v1) { u32x4 w; w.x = cvt_pk_bf16(v0[0], v0[1]); w.y = cvt_pk_bf16(v0[2], v0[3]); w.z = cvt_pk_bf16(v1[0], v1[1]); w.w = cvt_pk_bf16(v1[2], v1[3]); return w; }

struct EpiPlain {
    bf16_t* O0; bf16_t* O1; bf16_t* O2; bf16_t* O3; int ldc, nn;
    __device__ __forceinline__ void operator()(const f32x4 (&acc)[2][2][4][2], const Unit& u, int wr, int wc, int fr, int fq) const {
        const int kh = u.pn / nn, pn = u.pn - kh * nn; bf16_t* O = kh == 0 ? O0 : (kh == 1 ? O1 : (kh == 2 ? O2 : O3));
        const int row0 = u.pm * 256 + wr * 64 + fr, col0 = pn * 256 + wc * 32 + 8 * fq;
#pragma unroll
        for (int ai = 0; ai < 2; ++ai)
#pragma unroll
            for (int m = 0; m < 4; ++m) { bf16_t* rowp = O + (size_t)(row0 + ai * 128 + m * 16) * ldc + col0;
#pragma unroll
                for (int bj = 0; bj < 2; ++bj) *(u32x4*)(rowp + bj * 128) = pack8(acc[ai][bj][m][0], acc[ai][bj][m][1]); }
    }
};
struct EpiGU {
    bf16_t* O;
    __device__ __forceinline__ void operator()(const f32x4 (&acc)[2][2][4][2], const Unit& u, int wr, int wc, int fr, int fq) const {
        const int row0 = u.pm * 256 + wr * 64 + fr, col0 = u.pn * 128 + wc * 32 + 8 * fq;
#pragma unroll
        for (int ai = 0; ai < 2; ++ai)
#pragma unroll
            for (int m = 0; m < 4; ++m) { bf16_t* rowp = O + (size_t)(row0 + ai * 128 + m * 16) * FF + col0;
                const f32x4 o0 = silu_mul4(acc[ai][0][m][0], acc[ai][1][m][0]), o1 = silu_mul4(acc[ai][0][m][1], acc[ai][1][m][1]);
                *(u32x4*)rowp = pack8(o0, o1); }
    }
};
struct EpiCZ {
    bf16_t* GB; bf16_t* CZ; float* scp; float* scs;
    __device__ __forceinline__ void operator()(const f32x4 (&acc)[2][2][4][2], const Unit& u, int wr, int wc, int fr, int fq) const {
        const int row0 = u.pm * 256 + wr * 64 + fr;
        if (u.pn < 16) {
            const int col0 = u.pn * 128 + wc * 32 + 8 * fq;
#pragma unroll
            for (int ai = 0; ai < 2; ++ai)
#pragma unroll
                for (int m = 0; m < 4; ++m) { const int r = row0 + ai * 128 + m * 16;
                    const f32x4 c0 = acc[ai][0][m][0] * acc[ai][1][m][0], c1 = acc[ai][0][m][1] * acc[ai][1][m][1];
                    *(u32x4*)(CZ + (size_t)r * D + col0) = pack8(c0, c1);
                    float* sp = nullptr;
                    if (r < MP) { const int t = r & 2047; if (t >= 2046) sp = scp + (size_t)((r >> 11) * 2 + (t - 2046)) * D; }
                    else { const int t = r & 15; if (t >= 14) sp = scs + (size_t)(((r - MP) >> 4) * 2 + (t - 14)) * D; }
                    if (sp) { *(f32x4*)(sp + col0) = c0; *(f32x4*)(sp + col0 + 4) = c1; } }
        } else {
            const int col0 = (u.pn - 16) * 256 + wc * 32 + 8 * fq;
#pragma unroll
            for (int ai = 0; ai < 2; ++ai)
#pragma unroll
                for (int m = 0; m < 4; ++m) { bf16_t* rowp = GB + (size_t)(row0 + ai * 128 + m * 16) * D + col0;
#pragma unroll
                    for (int bj = 0; bj < 2; ++bj) *(u32x4*)(rowp + bj * 128) = pack8(acc[ai][bj][m][0], acc[ai][bj][m][1]); }
        }
    }
};
struct EpiGelu {
    bf16_t* O; const float* bias; float* stats;
    __device__ __forceinline__ void operator()(const f32x4 (&acc)[2][2][4][2], const Unit& u, int wr, int wc, int fr, int fq) const {
        const int row0 = u.pm * 256 + wr * 64 + fr, col0 = u.pn * 256 + wc * 32 + 8 * fq;
        f32x4 bv[2][2];
#pragma unroll
        for (int bj = 0; bj < 2; ++bj)
#pragma unroll
            for (int n = 0; n < 2; ++n) bv[bj][n] = *(const f32x4*)(bias + col0 + bj * 128 + 4 * n);
#pragma unroll
        for (int ai = 0; ai < 2; ++ai)
#pragma unroll
            for (int m = 0; m < 4; ++m) { const int r = row0 + ai * 128 + m * 16; bf16_t* rowp = O + (size_t)r * 4096 + col0; float s = 0.f, ss = 0.f;
#pragma unroll
                for (int bj = 0; bj < 2; ++bj) { const f32x4 v0 = gelu4(acc[ai][bj][m][0] + bv[bj][0]), v1 = gelu4(acc[ai][bj][m][1] + bv[bj][1]);
                    s += (v0[0] + v0[1]) + (v0[2] + v0[3]) + (v1[0] + v1[1]) + (v1[2] + v1[3]);
                    ss += (v0[0] * v0[0] + v0[1] * v0[1]) + (v0[2] * v0[2] + v0[3] * v0[3]) + (v1[0] * v1[0] + v1[1] * v1[1]) + (v1[2] * v1[2] + v1[3] * v1[3]);
                    *(u32x4*)(rowp + bj * 128) = pack8(v0, v1); }
                if (u.pn >= 8) { s += __shfl_xor(s, 16); s += __shfl_xor(s, 32); ss += __shfl_xor(ss, 16); ss += __shfl_xor(ss, 32);
                    if (fq == 0) *(f32x2*)(stats + ((size_t)r * 32 + (u.pn - 8) * 4 + wc) * 2) = (f32x2){s, ss}; } }
    }
};

__device__ __forceinline__ void transpose_item(const float* W, int K, int N, bf16_t* WT, int mode, LAS float* scr, int item, int lane) {
    const int nblk = N / 32, kb = item / nblk, nb = item % nblk, k0 = 64 * kb, n0 = 32 * nb;
    int row0;
    if (mode == 0) row0 = n0;
    else if (mode == 1) row0 = 256 * (n0 >> 7) + (n0 & 127);
    else if (mode == 2) row0 = 256 * (n0 >> 7) + 128 + (n0 & 127);
    else { const int part = n0 >> 11, c = n0 & 2047; row0 = part == 0 ? 4096 + c : (256 * (c >> 7) + (part == 2 ? 128 : 0) + (c & 127)); }
#pragma unroll 8
    for (int i = 0; i < 32; ++i) { const int kk = 2 * i + (lane >> 5); scr[kk * 33 + (lane & 31)] = __builtin_nontemporal_load(W + (size_t)(k0 + kk) * N + n0 + (lane & 31)); }
    asm volatile("s_waitcnt lgkmcnt(0)" ::: "memory");
    const int c = lane & 7;
#pragma unroll
    for (int j = 0; j < 4; ++j) { const int n = (lane >> 3) + 8 * j; const LAS float* s = scr + (8 * c) * 33 + n;
        u32x4 o; o.x = cvt_pk_bf16(s[0 * 33], s[1 * 33]); o.y = cvt_pk_bf16(s[2 * 33], s[3 * 33]); o.z = cvt_pk_bf16(s[4 * 33], s[5 * 33]); o.w = cvt_pk_bf16(s[6 * 33], s[7 * 33]);
        __builtin_nontemporal_store(o, (u32x4*)(WT + (size_t)(row0 + n) * K + k0 + 8 * c)); }
    asm volatile("s_waitcnt lgkmcnt(0)" ::: "memory");
}

constexpr int I_AIN = 32 * 192, I_SQ = 32 * 64, I_BIN = 32 * 128, I_GU = 32 * 176, I_DN = 88 * 64;
constexpr int CV_P0 = I_AIN + I_SQ, CV_T1 = CV_P0 + 2 * I_GU, CV_T3 = CV_T1 + I_DN + I_BIN + I_SQ, CV_T8 = CV_T3 + 2 * I_GU, CV_T10 = CV_T8 + I_DN;
__device__ __forceinline__ void convert_items(PP pp, LAS unsigned char* lds, int lo, int hi, int w, int nw, int wave, int lane) {
    LAS float* scr = (LAS float*)(lds + wave * 8448);
    unsigned char* ws = pp->ws;
    for (int it = lo + w; it < hi; it += nw) {
        int r = it;
        if (r < I_AIN) { transpose_item(pp->in[7], D, 3 * D, (bf16_t*)(ws + WS_WAIN), 3, scr, r, lane); continue; } r -= I_AIN;
        if (r < I_SQ) { transpose_item(pp->in[9], D, D, (bf16_t*)(ws + WS_WAOUT), 0, scr, r, lane); continue; } r -= I_SQ;
        if (r < I_GU) { transpose_item(pp->in[17], D, FF, (bf16_t*)(ws + WS_WGU0), 1, scr, r, lane); continue; } r -= I_GU;
        if (r < I_GU) { transpose_item(pp->in[18], D, FF, (bf16_t*)(ws + WS_WGU0), 2, scr, r, lane); continue; } r -= I_GU;
        if (r < I_DN) { transpose_item(pp->in[19], FF, D, (bf16_t*)(ws + WS_WDN0), 0, scr, r, lane); continue; } r -= I_DN;
        if (r < I_BIN) { transpose_item(pp->in[10], D, 2 * D, (bf16_t*)(ws + WS_WBIN), 0, scr, r, lane); continue; } r -= I_BIN;
        if (r < I_SQ) { transpose_item(pp->in[16], D, D, (bf16_t*)(ws + WS_WBOUT), 0, scr, r, lane); continue; } r -= I_SQ;
        if (r < I_GU) { transpose_item(pp->in[17] + (size_t)D * FF, D, FF, (bf16_t*)(ws + WS_WGU1), 1, scr, r, lane); continue; } r -= I_GU;
        if (r < I_GU) { transpose_item(pp->in[18] + (size_t)D * FF, D, FF, (bf16_t*)(ws + WS_WGU1), 2, scr, r, lane); continue; } r -= I_GU;
        transpose_item(pp->in[19] + (size_t)FF * D, FF, D, (bf16_t*)(ws + WS_WDN1), 0, scr, r, lane);
    }
}
__device__ __forceinline__ void tail_convert(PP pp, LAS unsigned char* lds, int nwg, int G, int lo, int hi) {
    const int rem = nwg % G;
    if ((int)blockIdx.x < rem || lo >= hi) return;
    int tid = threadIdx.x; asm volatile("" : "+v"(tid));
    const int wave = __builtin_amdgcn_readfirstlane(tid >> 6), lane = tid & 63;
    convert_items(pp, lds, lo, hi, ((int)blockIdx.x - rem) * NWAVES + wave, (G - rem) * NWAVES, wave, lane);
}

__device__ __forceinline__ void phase0(PP pp, LAS unsigned char* lds, int gw, int NGW, int wave, int lane) {
    unsigned char* ws = pp->ws;
    convert_items(pp, lds, 0, CV_P0, gw, NGW, wave, lane);
    bf16_t* H = (bf16_t*)(ws + WS_H);
    const float* gpre = pp->in[3];
    for (int row = gw; row < M; row += 2 * NGW) {
        const int rowB = row + NGW; const bool hasB = rowB < M;
        const float* xa = row < MP ? pp->in[0] + (size_t)row * D : pp->in[1] + (size_t)(row - MP) * D;
        const float* xbp = !hasB ? xa : (rowB < MP ? pp->in[0] + (size_t)rowB * D : pp->in[1] + (size_t)(rowB - MP) * D);
        f32x4 va[4][2], vb[4][2]; float sa = 0.f, sb = 0.f;
#pragma unroll
        for (int j = 0; j < 4; ++j)
#pragma unroll
            for (int h = 0; h < 2; ++h) va[j][h] = __builtin_nontemporal_load((const f32x4*)(xa + 512 * j + 8 * lane + 4 * h));
#pragma unroll
        for (int j = 0; j < 4; ++j)
#pragma unroll
            for (int h = 0; h < 2; ++h) vb[j][h] = __builtin_nontemporal_load((const f32x4*)(xbp + 512 * j + 8 * lane + 4 * h));
#pragma unroll
        for (int j = 0; j < 4; ++j)
#pragma unroll
            for (int h = 0; h < 2; ++h) { const f32x4 v = va[j][h]; sa += (v[0] * v[0] + v[1] * v[1]) + (v[2] * v[2] + v[3] * v[3]); const f32x4 w = vb[j][h]; sb += (w[0] * w[0] + w[1] * w[1]) + (w[2] * w[2] + w[3] * w[3]); }
        const float ra = 1.0f / sqrtf(wave_sum(sa) * (1.0f / D) + EPS), rb = 1.0f / sqrtf(wave_sum(sb) * (1.0f / D) + EPS);
#pragma unroll
        for (int j = 0; j < 4; ++j) { const f32x4 g0 = *(const f32x4*)(gpre + 512 * j + 8 * lane), g1 = *(const f32x4*)(gpre + 512 * j + 8 * lane + 4);
            *(u32x4*)(H + (size_t)row * D + 512 * j + 8 * lane) = pack8(va[j][0] * ra * g0, va[j][1] * ra * g1);
            if (hasB) *(u32x4*)(H + (size_t)rowB * D + 512 * j + 8 * lane) = pack8(vb[j][0] * rb * g0, vb[j][1] * rb * g1); }
    }
}

__device__ __forceinline__ void unpack8(u32x4 w, float (&f)[8]) { f[0] = bf_lo(w.x); f[1] = bf_hi(w.x); f[2] = bf_lo(w.y); f[3] = bf_hi(w.y); f[4] = bf_lo(w.z); f[5] = bf_hi(w.z); f[6] = bf_lo(w.w); f[7] = bf_hi(w.w); }
__device__ __forceinline__ void conv_hist(const float* cache, int s0, int hi, int c, float (&p)[8]) {
    if (s0 < MP) {
#pragma unroll
        for (int e = 0; e < 8; ++e) p[e] = 0.f;
    } else { const float* hp = cache + (size_t)(((s0 - MP) >> 4) * 2 + hi) * D + c; const f32x4 a = *(const f32x4*)hp, b = *(const f32x4*)(hp + 4);
        p[0] = a[0]; p[1] = a[1]; p[2] = a[2]; p[3] = a[3]; p[4] = b[0]; p[5] = b[1]; p[6] = b[2]; p[7] = b[3]; }
}
__device__ __forceinline__ void conv_phase(PP pp, int G) {
    unsigned char* ws = pp->ws;
    const bf16_t* GB = (const bf16_t*)(ws + WS_BIG); const bf16_t* CZ = GB + (size_t)M * D; bf16_t* YIN = (bf16_t*)(ws + WS_YIN);
    const float* cw = pp->in[8]; const float* cache = pp->in[2];
    int tid = threadIdx.x; asm volatile("" : "+v"(tid));
    constexpr int R = 17; static_assert(M % R == 0, "row blocks");
    for (int item = blockIdx.x * NTHREADS + tid; item < (M / R) * 256; item += G * NTHREADS) {
        const int cb = item & 255, rb = item >> 8, r0 = rb * R, c = cb * 8;
        float w0[8], w1[8], w2[8], p2[8], p1[8];
#pragma unroll
        for (int e = 0; e < 8; ++e) { w0[e] = cw[c + e]; w1[e] = cw[D + c + e]; w2[e] = cw[2 * D + c + e]; }
        { const int s0 = r0 < MP ? (r0 & ~2047) : MP + ((r0 - MP) & ~15);
          if (r0 - 2 >= s0) unpack8(*(const u32x4*)(CZ + (size_t)(r0 - 2) * D + c), p2); else conv_hist(cache, s0, r0 - s0, c, p2);
          if (r0 - 1 >= s0) unpack8(*(const u32x4*)(CZ + (size_t)(r0 - 1) * D + c), p1); else conv_hist(cache, s0, 1, c, p1); }
#pragma unroll
        for (int ch = 0; ch < 2; ++ch) { constexpr int CH = 9; const int i0 = ch * CH, i1 = ch ? R : CH;
            u32x4 czr[CH], gbr[CH];
#pragma unroll
            for (int i = i0; i < i1; ++i) { const size_t off = (size_t)(r0 + i) * D + c; czr[i - i0] = __builtin_nontemporal_load((const u32x4*)(CZ + off)); gbr[i - i0] = __builtin_nontemporal_load((const u32x4*)(GB + off)); }
#pragma unroll
            for (int i = i0; i < i1; ++i) { const int r = r0 + i; const size_t off = (size_t)r * D + c; float cu[8], gb[8], y[8];
                if (i > 0) { const bool start = r < MP ? ((r & 2047) == 0) : (((r - MP) & 15) == 0); if (start) { conv_hist(cache, r, 0, c, p2); conv_hist(cache, r, 1, c, p1); } }
                unpack8(czr[i - i0], cu); unpack8(gbr[i - i0], gb);
#pragma unroll
                for (int e = 0; e < 8; ++e) { y[e] = gb[e] * (w0[e] * p2[e] + w1[e] * p1[e] + w2[e] * cu[e]); p2[e] = p1[e]; p1[e] = cu[e]; }
                u32x4 o; o.x = cvt_pk_bf16(y[0], y[1]); o.y = cvt_pk_bf16(y[2], y[3]); o.z = cvt_pk_bf16(y[4], y[5]); o.w = cvt_pk_bf16(y[6], y[7]);
                *(u32x4*)(YIN + off) = o; } }
    }
}

struct RnRow { f32x4 xf[4][2]; u32x4 xr[4]; u32x4 mr[4]; };
__device__ __forceinline__ void rn_load(RnRow& R, int row, const float* xp, const bf16_t* xb, const bf16_t* mb, int lane) {
    if (xp) {
#pragma unroll
        for (int j = 0; j < 4; ++j) { R.xf[j][0] = __builtin_nontemporal_load((const f32x4*)(xp + (size_t)row * D + 512 * j + 8 * lane)); R.xf[j][1] = __builtin_nontemporal_load((const f32x4*)(xp + (size_t)row * D + 512 * j + 8 * lane + 4)); }
    } else {
#pragma unroll
        for (int j = 0; j < 4; ++j) R.xr[j] = __builtin_nontemporal_load((const u32x4*)(xb + (size_t)row * D + 512 * j + 8 * lane));
    }
#pragma unroll
    for (int j = 0; j < 4; ++j) R.mr[j] = __builtin_nontemporal_load((const u32x4*)(mb + (size_t)row * D + 512 * j + 8 * lane));
}
__device__ __forceinline__ void rn_finish(RnRow& R, int row, bool from_f32, bf16_t* xb, float* xout, const float* gpost, const float* gnext, bf16_t* H, int lane) {
    float mf[4][8]; f32x4 xv[4][2]; float ss = 0.f;
#pragma unroll
    for (int j = 0; j < 4; ++j) {
        if (from_f32) { xv[j][0] = R.xf[j][0]; xv[j][1] = R.xf[j][1]; }
        else { float t[8]; unpack8(R.xr[j], t); xv[j][0] = (f32x4){t[0], t[1], t[2], t[3]}; xv[j][1] = (f32x4){t[4], t[5], t[6], t[7]}; }
        unpack8(R.mr[j], mf[j]);
#pragma unroll
        for (int e = 0; e < 8; ++e) ss += mf[j][e] * mf[j][e]; }
    const float r = 1.0f / sqrtf(wave_sum(ss) * (1.0f / D) + EPS);
    float ss2 = 0.f;
#pragma unroll
    for (int j = 0; j < 4; ++j) { const f32x4 g0 = *(const f32x4*)(gpost + 512 * j + 8 * lane), g1 = *(const f32x4*)(gpost + 512 * j + 8 * lane + 4);
        const f32x4 m0 = (f32x4){mf[j][0], mf[j][1], mf[j][2], mf[j][3]}, m1 = (f32x4){mf[j][4], mf[j][5], mf[j][6], mf[j][7]};
        xv[j][0] = xv[j][0] + m0 * r * g0; xv[j][1] = xv[j][1] + m1 * r * g1;
#pragma unroll
        for (int h = 0; h < 2; ++h) { const f32x4 v = xv[j][h]; ss2 += (v[0] * v[0] + v[1] * v[1]) + (v[2] * v[2] + v[3] * v[3]); }
        if (gnext) *(u32x4*)(xb + (size_t)row * D + 512 * j + 8 * lane) = pack8(xv[j][0], xv[j][1]);
        else { *(f32x4*)(xout + (size_t)row * D + 512 * j + 8 * lane) = xv[j][0]; *(f32x4*)(xout + (size_t)row * D + 512 * j + 8 * lane + 4) = xv[j][1]; } }
    if (gnext) {
        const float r2 = 1.0f / sqrtf(wave_sum(ss2) * (1.0f / D) + EPS);
#pragma unroll
        for (int j = 0; j < 4; ++j) { const f32x4 g0 = *(const f32x4*)(gnext + 512 * j + 8 * lane), g1 = *(const f32x4*)(gnext + 512 * j + 8 * lane + 4);
            *(u32x4*)(H + (size_t)row * D + 512 * j + 8 * lane) = pack8(xv[j][0] * r2 * g0, xv[j][1] * r2 * g1); }
    }
}
__device__ __forceinline__ void resnorm_phase(const float* xp, const float* xs, bf16_t* xb, float* xout, const bf16_t* mb, const bf16_t* part, const float* gpost, const float* gnext, bf16_t* H, int gw, int NGW, int lane, LAS unsigned char* lds) {
    const bool quarter = (NGW == 4 * MS);
    if (quarter) {
        for (int row = gw; row < MP; row += 2 * NGW) { RnRow A, B;
            rn_load(A, row, xp, xb, mb, lane); rn_load(B, row + NGW, xp, xb, mb, lane);
            rn_finish(A, row, xp != nullptr, xb, xout, gpost, gnext, H, lane); rn_finish(B, row + NGW, xp != nullptr, xb, xout, gpost, gnext, H, lane); }
    }
    for (int row = gw; row < (quarter ? 0 : M); row += NGW) {
        float mf[4][8]; f32x4 xv[4][2]; float ss = 0.f;
        if (xp) { const float* xr = row < MP ? xp + (size_t)row * D : xs + (size_t)(row - MP) * D;
#pragma unroll
            for (int j = 0; j < 4; ++j) { xv[j][0] = *(const f32x4*)(xr + 512 * j + 8 * lane); xv[j][1] = *(const f32x4*)(xr + 512 * j + 8 * lane + 4); }
        } else {
#pragma unroll
            for (int j = 0; j < 4; ++j) { float t[8]; unpack8(__builtin_nontemporal_load((const u32x4*)(xb + (size_t)row * D + 512 * j + 8 * lane)), t); xv[j][0] = (f32x4){t[0], t[1], t[2], t[3]}; xv[j][1] = (f32x4){t[4], t[5], t[6], t[7]}; }
        }
#pragma unroll
        for (int j = 0; j < 4; ++j) {
            if (part && row >= MP) { const size_t o = (size_t)(row - MP) * D + 512 * j + 8 * lane; float p1[8], p2[8], p3[8];
                unpack8(__builtin_nontemporal_load((const u32x4*)(part + o)), mf[j]); unpack8(__builtin_nontemporal_load((const u32x4*)(part + (size_t)MS * D + o)), p1);
                unpack8(__builtin_nontemporal_load((const u32x4*)(part + (size_t)2 * MS * D + o)), p2); unpack8(__builtin_nontemporal_load((const u32x4*)(part + (size_t)3 * MS * D + o)), p3);
#pragma unroll
                for (int e = 0; e < 8; ++e) mf[j][e] = (mf[j][e] + p1[e]) + (p2[e] + p3[e]);
            } else unpack8(__builtin_nontemporal_load((const u32x4*)(mb + (size_t)row * D + 512 * j + 8 * lane)), mf[j]);
#pragma unroll
            for (int e = 0; e < 8; ++e) ss += mf[j][e] * mf[j][e]; }
        const float r = 1.0f / sqrtf(wave_sum(ss) * (1.0f / D) + EPS);
        float ss2 = 0.f;
#pragma unroll
        for (int j = 0; j < 4; ++j) { const f32x4 g0 = *(const f32x4*)(gpost + 512 * j + 8 * lane), g1 = *(const f32x4*)(gpost + 512 * j + 8 * lane + 4);
            const f32x4 m0 = (f32x4){mf[j][0], mf[j][1], mf[j][2], mf[j][3]}, m1 = (f32x4){mf[j][4], mf[j][5], mf[j][6], mf[j][7]};
            xv[j][0] = xv[j][0] + m0 * r * g0; xv[j][1] = xv[j][1] + m1 * r * g1;
#pragma unroll
            for (int h = 0; h < 2; ++h) { const f32x4 v = xv[j][h]; ss2 += (v[0] * v[0] + v[1] * v[1]) + (v[2] * v[2] + v[3] * v[3]); }
            if (gnext) *(u32x4*)(xb + (size_t)row * D + 512 * j + 8 * lane) = pack8(xv[j][0], xv[j][1]);
            else { *(f32x4*)(xout + (size_t)row * D + 512 * j + 8 * lane) = xv[j][0]; *(f32x4*)(xout + (size_t)row * D + 512 * j + 8 * lane + 4) = xv[j][1]; } }
        if (gnext) {
            const float r2 = 1.0f / sqrtf(wave_sum(ss2) * (1.0f / D) + EPS);
#pragma unroll
            for (int j = 0; j < 4; ++j) { const f32x4 g0 = *(const f32x4*)(gnext + 512 * j + 8 * lane), g1 = *(const f32x4*)(gnext + 512 * j + 8 * lane + 4);
                *(u32x4*)(H + (size_t)row * D + 512 * j + 8 * lane) = pack8(xv[j][0] * r2 * g0, xv[j][1] * r2 * g1); }
        }
    }
    if (quarter) {
        const int wave = (gw & 7), q = wave & 3, row = MP + (gw >> 2); const size_t off = (size_t)row * D + 512 * q + 8 * lane;
        LAS float* red = (LAS float*)lds;
        float t[8], mf[8];
        if (xp) { const float* xr = xs + (size_t)(row - MP) * D + 512 * q + 8 * lane; const f32x4 a = *(const f32x4*)xr, b = *(const f32x4*)(xr + 4); t[0] = a[0]; t[1] = a[1]; t[2] = a[2]; t[3] = a[3]; t[4] = b[0]; t[5] = b[1]; t[6] = b[2]; t[7] = b[3]; }
        else unpack8(__builtin_nontemporal_load((const u32x4*)(xb + off)), t);
        if (part) { const size_t o = off - (size_t)MP * D; float p1[8], p2[8], p3[8];
            unpack8(__builtin_nontemporal_load((const u32x4*)(part + o)), mf); unpack8(__builtin_nontemporal_load((const u32x4*)(part + (size_t)MS * D + o)), p1);
            unpack8(__builtin_nontemporal_load((const u32x4*)(part + (size_t)2 * MS * D + o)), p2); unpack8(__builtin_nontemporal_load((const u32x4*)(part + (size_t)3 * MS * D + o)), p3);
#pragma unroll
            for (int e = 0; e < 8; ++e) mf[e] = (mf[e] + p1[e]) + (p2[e] + p3[e]);
        } else unpack8(__builtin_nontemporal_load((const u32x4*)(mb + off)), mf);
        float ss = 0.f;
#pragma unroll
        for (int e = 0; e < 8; ++e) ss += mf[e] * mf[e];
        ss = wave_sum(ss);
        __syncthreads();
        if (lane == 0) red[wave] = ss;
        __syncthreads();
        const int w4 = wave & 4;
        const float r = 1.0f / sqrtf(((red[w4] + red[w4 + 1]) + (red[w4 + 2] + red[w4 + 3])) * (1.0f / D) + EPS);
        const f32x4 g0 = *(const f32x4*)(gpost + 512 * q + 8 * lane), g1 = *(const f32x4*)(gpost + 512 * q + 8 * lane + 4);
        f32x4 x0 = (f32x4){t[0], t[1], t[2], t[3]} + (f32x4){mf[0], mf[1], mf[2], mf[3]} * r * g0, x1 = (f32x4){t[4], t[5], t[6], t[7]} + (f32x4){mf[4], mf[5], mf[6], mf[7]} * r * g1;
        if (gnext) {
            *(u32x4*)(xb + off) = pack8(x0, x1);
            float ss2 = (x0[0] * x0[0] + x0[1] * x0[1]) + (x0[2] * x0[2] + x0[3] * x0[3]) + (x1[0] * x1[0] + x1[1] * x1[1]) + (x1[2] * x1[2] + x1[3] * x1[3]);
            ss2 = wave_sum(ss2);
            if (lane == 0) red[8 + wave] = ss2;
            __syncthreads();
            const float r2 = 1.0f / sqrtf(((red[8 + w4] + red[9 + w4]) + (red[10 + w4] + red[11 + w4])) * (1.0f / D) + EPS);
            const f32x4 n0 = *(const f32x4*)(gnext + 512 * q + 8 * lane), n1 = *(const f32x4*)(gnext + 512 * q + 8 * lane + 4);
            *(u32x4*)(H + off) = pack8(x0 * r2 * n0, x1 * r2 * n1);
        } else { *(f32x4*)(xout + off) = x0; *(f32x4*)(xout + off + 4) = x1; }
    }
}

__device__ __forceinline__ void sgu_phase(PP pp, LAS unsigned char* lds, int G) {
    unsigned char* ws = pp->ws;
    LAS bf16_t* Aw = (LAS bf16_t*)lds;
    LAS bf16_t* Vt = (LAS bf16_t*)(lds + 34816);
    LAS float* St = (LAS float*)(lds + 69632);
    const bf16_t* ZZ = (const bf16_t*)(ws + WS_BIG); const float* stats = (const float*)(ws + WS_STATS); bf16_t* YIN = (bf16_t*)(ws + WS_YIN);
    const float* ln_g = pp->in[12]; const float* ln_b = pp->in[13]; const float* w_s = pp->in[14]; const float* b_s = pp->in[15];
    float* st_sgu = pp->out + O_SGU;
    int tid = threadIdx.x; asm volatile("" : "+v"(tid));
    const int wid = tid >> 6, lane = tid & 63, wr = wid >> 2, wc = wid & 3, fr = lane & 15, fq = lane >> 4;
    for (int unit = blockIdx.x; unit < (M / 128) * 16; unit += G) {
        const int rt = unit >> 4, g = unit & 15, r0 = rt * 128, c0 = g * 128; const bool sample = rt >= (MP / 128);
        const int ch = lane & 15, cch = c0 + 8 * ch;
        const f32x4 lg0 = *(const f32x4*)(ln_g + cch), lg1 = *(const f32x4*)(ln_g + cch + 4), lb0 = *(const f32x4*)(ln_b + cch), lb1 = *(const f32x4*)(ln_b + cch + 4);
        u32x4 raw[4], uraw[4];
#pragma unroll
        for (int it = 0; it < 4; ++it) raw[it] = *(const u32x4*)(ZZ + (size_t)(r0 + wid * 16 + it * 4 + (lane >> 4)) * 4096 + 2048 + cch);
#pragma unroll
        for (int m = 0; m < 4; ++m) uraw[m] = *(const u32x4*)(ZZ + (size_t)(r0 + 64 * wr + 16 * m + fr) * 4096 + c0 + 32 * wc + 8 * fq);
        __syncthreads();
        if (tid < 128) { const f32x4* sp = (const f32x4*)(stats + (size_t)(r0 + tid) * 64); float s = 0.f, ss = 0.f;
#pragma unroll
            for (int q = 0; q < 16; ++q) { const f32x4 v = sp[q]; s += v[0] + v[2]; ss += v[1] + v[3]; }
            const float mean = s * (1.0f / 2048.0f), var = ss * (1.0f / 2048.0f) - mean * mean;
            St[2 * tid] = mean; St[2 * tid + 1] = 1.0f / sqrtf(fmaxf(var, 0.f) + EPS); }
        const float* wg = w_s + (size_t)g * 128 * 128;
#pragma unroll
        for (int q = 0; q < 8; ++q) { const int idx = q * NTHREADS + tid, i = idx >> 5, j4 = (idx & 31) * 4;
            int lim, so;
            if (!sample) { so = i * 128 + j4; lim = i - j4; }
            else { const int ii = i & 15, jj = j4 & 15; so = ii * 128 + jj; lim = ((i >> 4) == (j4 >> 4)) ? ii - jj : -1; }
            f32x4 w = *(const f32x4*)(wg + so);
#pragma unroll
            for (int e = 0; e < 4; ++e) w[e] = __uint_as_float(__float_as_uint(w[e]) & ~(unsigned)((lim - e) >> 31));
            u32x2 o; o.x = cvt_pk_bf16(w[0], w[1]); o.y = cvt_pk_bf16(w[2], w[3]);
            *(LAS u32x2*)(Aw + i * 136 + j4) = o; }
        __syncthreads();
        { const int c = cch;
#pragma unroll
            for (int it = 0; it < 4; ++it) { const int j = wid * 16 + it * 4 + (lane >> 4), r = r0 + j; const float mean = St[2 * j], rstd = St[2 * j + 1]; float v[8];
                unpack8(raw[it], v);
#pragma unroll
                for (int e = 0; e < 8; ++e) v[e] = (v[e] - mean) * rstd * (e < 4 ? lg0[e & 3] : lg1[e & 3]) + (e < 4 ? lb0[e & 3] : lb1[e & 3]);
                if (sample) { float* sp = st_sgu + (size_t)(r - MP) * 2048 + c; *(f32x4*)sp = (f32x4){v[0], v[1], v[2], v[3]}; *(f32x4*)(sp + 4) = (f32x4){v[4], v[5], v[6], v[7]}; }
                const int jo = (((j >> 3) ^ ch) << 3) + (j & 7);
#pragma unroll
                for (int e = 0; e < 8; e += 2) { const unsigned pk = cvt_pk_bf16(v[e], v[e + 1]); Vt[(8 * ch + e) * 136 + jo] = (bf16_t)(pk & 0xffffu); Vt[(8 * ch + e + 1) * 136 + jo] = (bf16_t)(pk >> 16); } }
        }
        __syncthreads();
        f32x4 acc[4][2];
#pragma unroll
        for (int m = 0; m < 4; ++m)
#pragma unroll
            for (int n = 0; n < 2; ++n) acc[m][n] = (f32x4){0.f, 0.f, 0.f, 0.f};
#pragma unroll
        for (int k = 0; k < 4; ++k) { bf16x8 Af[4], Bf[2];
#pragma unroll
            for (int m = 0; m < 4; ++m) Af[m] = *(const LAS bf16x8*)(Aw + (64 * wr + 16 * m + fr) * 136 + 32 * k + 8 * fq);
#pragma unroll
            for (int n = 0; n < 2; ++n) { const int d = 32 * wc + 8 * (fr >> 2) + 4 * n + (fr & 3); Bf[n] = *(const LAS bf16x8*)(Vt + d * 136 + (((4 * k + fq) ^ ((d >> 3) & 15)) << 3)); }
#pragma unroll
            for (int m = 0; m < 4; ++m)
#pragma unroll
                for (int n = 0; n < 2; ++n) acc[m][n] = __builtin_amdgcn_mfma_f32_16x16x32_bf16(Bf[n], Af[m], acc[m][n], 0, 0, 0); }
#pragma unroll
        for (int m = 0; m < 4; ++m) { const int i = 64 * wr + 16 * m + fr, r = r0 + i; const float bias = b_s[g * 128 + (sample ? (i & 15) : i)];
            const int d = c0 + 32 * wc + 8 * fq; float u[8]; unpack8(uraw[m], u);
            const f32x4 o0 = (f32x4){u[0], u[1], u[2], u[3]} * (acc[m][0] + bias), o1 = (f32x4){u[4], u[5], u[6], u[7]} * (acc[m][1] + bias);
            *(u32x4*)(YIN + (size_t)r * D + d) = pack8(o0, o1); }
    }
    __syncthreads();
}

#define XB_TMO      128
#define XB_XCNT(j)  (256  + 64 * (j))
#define XB_XSUB(j)  (1280 + 64 * (j))
#define XB_XGEN(j)  (2304 + 64 * (j))
#define XB_TOP      3328
#define XB_TOPGEN   3392
#define XCD_BAR_WORDS 3456
#define XB_SPIN_CAP (1u << 18)
__device__ __forceinline__ unsigned xb_ld(unsigned* p)              { return __hip_atomic_load(p, __ATOMIC_RELAXED, __HIP_MEMORY_SCOPE_AGENT); }
__device__ __forceinline__ unsigned xb_add(unsigned* p, unsigned v) { return __hip_atomic_fetch_add(p, v, __ATOMIC_RELAXED, __HIP_MEMORY_SCOPE_AGENT); }
__device__ __forceinline__ unsigned xb_xcc_id() { return (unsigned)__builtin_amdgcn_s_getreg((3 << 11) | 20) & 0xFu; }
#define XB_SPIN(cond, bar) do { unsigned _sp = 0; while (cond) { __builtin_amdgcn_s_sleep(1); \
    if ((++_sp & 255u) == 0u) { if (xb_ld(&(bar)[XB_TMO])) break; if (_sp > XB_SPIN_CAP) { atomicAdd(&(bar)[XB_TMO], 1u); break; } } } } while (0)
__device__ __forceinline__ void xcd_barrier_complete(unsigned* bar, unsigned x, unsigned& nloc, unsigned& nx) {
    const unsigned G = gridDim.x * gridDim.y * gridDim.z;
    unsigned sum, cnt, mine, sp = 0u;
    for (;;) {
        sum = 0u; cnt = 0u; mine = 0u;
#pragma unroll
        for (unsigned j = 0; j < 16; ++j) { const unsigned c = xb_ld(&bar[XB_XCNT(j)]); sum += c; cnt += (c > 0u) ? 1u : 0u; mine = (j == x) ? c : mine; }
        if (sum == G) break;
        __builtin_amdgcn_s_sleep(1);
        if ((++sp & 255u) == 0u) { if (xb_ld(&bar[XB_TMO])) break; if (sp > XB_SPIN_CAP) { atomicAdd(&bar[XB_TMO], 1u); break; } }
    }
    nloc = mine > 0u ? mine : 1u; nx = cnt > 0u ? cnt : 1u;
}
__device__ __forceinline__ void xcd_barrier(unsigned* bar, volatile LAS unsigned* st) {
    asm volatile("s_waitcnt vmcnt(0)" ::: "memory");
    __syncthreads();
    if (threadIdx.x == 0) {
        __builtin_amdgcn_s_waitcnt(0);
        const unsigned x = xb_xcc_id();
        unsigned nloc = st[0], nx = st[1];
        if (nloc == 0u) { xcd_barrier_complete(bar, x, nloc, nx); st[0] = nloc; st[1] = nx; }
        const unsigned old = xb_add(&bar[XB_XSUB(x)], 1u);
        const unsigned gen = old / nloc;
        if (old + 1u == (gen + 1u) * nloc) {
            __builtin_amdgcn_fence(__ATOMIC_RELEASE, "agent");
            asm volatile("s_waitcnt vmcnt(0)" ::: "memory");
            const unsigned og = xb_add(&bar[XB_TOP], 1u);
            const unsigned tg = og / nx;
            if (og + 1u == (tg + 1u) * nx) xb_add(&bar[XB_TOPGEN], 1u);
            else XB_SPIN(xb_ld(&bar[XB_TOPGEN]) == tg, bar);
            __builtin_amdgcn_fence(__ATOMIC_ACQUIRE, "agent");
            xb_add(&bar[XB_XGEN(x)], 1u);
            asm volatile("s_waitcnt vmcnt(0)" ::: "memory");
        } else {
            XB_SPIN(xb_ld(&bar[XB_XGEN(x)]) == gen, bar);
            __builtin_amdgcn_fence(__ATOMIC_ACQUIRE, "agent");
            asm volatile("s_waitcnt vmcnt(0)" ::: "memory");
        }
    }
    __syncthreads();
}

__global__ void __launch_bounds__(NTHREADS, 2) mega(Params p_arg) {
    extern __shared__ __attribute__((aligned(16))) unsigned char lds_raw[];
    LAS unsigned char* lds = (LAS unsigned char*)lds_raw;
    cg::grid_group grid = cg::this_grid();
    PP pp = (PP)__builtin_amdgcn_kernarg_segment_ptr();
    const int G = gridDim.x, NGW = G * NWAVES;
#define LANE_IDS() int tid = threadIdx.x; asm volatile("" : "+v"(tid)); const int wave = __builtin_amdgcn_readfirstlane(tid >> 6), lane = tid & 63, gw = blockIdx.x * NWAVES + wave

    if (threadIdx.x < 2) ((volatile LAS unsigned*)(lds + LDS_STAGE))[threadIdx.x] = 0u;
    if (threadIdx.x == 0) (void)xb_add(&((unsigned*)(pp->ws + WS_BAR))[XB_XCNT(xb_xcc_id())], 1u);
    if (G > 0x40000000) grid.sync();
    for (int rep = 0; rep < REP_P0; ++rep) { LANE_IDS(); phase0(pp, lds, gw, NGW, wave, lane); }
    GSYNC();

#pragma nounroll
    for (int layer = 0; layer < 2; ++layer) {
        FRESH(pp);
        if (layer == 0) {
            { unsigned char* ws = pp->ws; float* out = pp->out; bf16_t* BIG = (bf16_t*)(ws + WS_BIG);
              pg8::Gemm g{(const bf16_t*)(ws + WS_H), (const bf16_t*)(ws + WS_WAIN), M, 3 * D, D, D, 3 * D / 256}; pg8::StaticOrder S; S.init(M, 3 * D, G, (int)blockIdx.x);
              EpiCZ E{BIG, BIG + (size_t)M * D, out + O_SCP, out + O_SCS};
              for (int rep = 0; rep < REP_GEMM; ++rep) pg8::gemm_phase<EpiCZ>(lds, g, S, E);
              tail_convert(pp, lds, S.nwg, G, CV_P0, CV_T1); }
            GSYNC();
            FRESH(pp);
            for (int rep = 0; rep < REP_MIX; ++rep) conv_phase(pp, G);
            GSYNC();
        } else {
            { unsigned char* ws = pp->ws;
              pg8::Gemm g{(const bf16_t*)(ws + WS_H), (const bf16_t*)(ws + WS_WBIN), M, 2 * D, D, D, 2 * D / 256}; pg8::StaticOrder S; S.init(M, 2 * D, G, (int)blockIdx.x);
              EpiGelu E{(bf16_t*)(ws + WS_BIG), pp->in[11], (float*)(ws + WS_STATS)};
              for (int rep = 0; rep < REP_GEMM; ++rep) pg8::gemm_phase<EpiGelu>(lds, g, S, E);
              tail_convert(pp, lds, S.nwg, G, CV_T3, CV_T8); }
            GSYNC();
            FRESH(pp);
            for (int rep = 0; rep < REP_MIX; ++rep) sgu_phase(pp, lds, G);
            GSYNC();
        }
#pragma nounroll
        for (int sub = 0; sub < 2; ++sub) {
            if (sub == 1) {
                FRESH(pp);
                unsigned char* ws = pp->ws;
                pg8::Gemm g{(const bf16_t*)(ws + WS_H), (const bf16_t*)(ws + (layer ? WS_WGU1 : WS_WGU0)), M, 2 * FF, D, D, 2 * FF / 256}; pg8::StaticOrder S; S.init(M, 2 * FF, G, (int)blockIdx.x);
                EpiGU E{(bf16_t*)(ws + WS_BIG)};
                for (int rep = 0; rep < REP_GEMM; ++rep) pg8::gemm_phase<EpiGU>(lds, g, S, E);
                GSYNC();
            }
            { FRESH(pp);
              unsigned char* ws = pp->ws;
              const bf16_t* A = (const bf16_t*)(ws + (sub ? WS_BIG : WS_YIN)); const int K = sub ? FF : D;
              const bf16_t* Bt = (const bf16_t*)(ws + (sub ? (layer ? WS_WDN1 : WS_WDN0) : (layer ? WS_WBOUT : WS_WAOUT)));
              bf16_t* MB = (bf16_t*)(ws + WS_MB); bf16_t* PT = (bf16_t*)(ws + WS_PART);
              { pg8::Gemm g{A, Bt, MP, D, K, K, D / 256}; pg8::StaticOrder S; S.init(MP, D, G, (int)blockIdx.x);
                EpiPlain E{MB, MB, MB, MB, D, D / 256};
                pg8::gemm_phase<EpiPlain>(lds, g, S, E); }
              const int ks = 4;
              { pg8::Gemm g{A + (size_t)MP * K, Bt, MS, D * ks, K / ks, K, D / 256}; pg8::StaticOrder S; S.init(MS, D * ks, G, (int)blockIdx.x);
                bf16_t* MBS = MB + (size_t)MP * D;
                EpiPlain E{ks == 1 ? MBS : PT, PT + (size_t)MS * D, PT + (size_t)2 * MS * D, PT + (size_t)3 * MS * D, D, D / 256};
                pg8::gemm_phase<EpiPlain>(lds, g, S, E);
                { const int lo = layer == 0 ? (sub ? CV_T1 + I_DN : CV_T1) : CV_T8, hi = layer == 0 ? (sub ? CV_T3 : CV_T1 + I_DN) : (sub ? CV_T8 : CV_T10);
                  tail_convert(pp, lds, G + S.nwg, G, lo, hi); } } }
            GSYNC();
            { FRESH(pp); LANE_IDS();
              unsigned char* ws = pp->ws;
              const bool first = (layer == 0 && sub == 0), lastp = (layer == 1 && sub == 1);
              const float* xp = first ? pp->in[0] : nullptr; const float* xs = first ? pp->in[1] : nullptr;
              const float* gpost = (sub ? pp->in[6] : pp->in[4]) + layer * D;
              const float* gnext = lastp ? nullptr : (sub ? pp->in[3] + D : pp->in[5] + layer * D);
              resnorm_phase(xp, xs, (bf16_t*)(ws + WS_XB), pp->out + O_Y, (const bf16_t*)(ws + WS_MB), (const bf16_t*)(ws + WS_PART), gpost, gnext, (bf16_t*)(ws + WS_H), gw, NGW, lane, lds); }
            if (!(layer == 1 && sub == 1)) GSYNC();
        }
    }
}

extern "C" void kernel_launch(void* const* d_in, const int* in_sizes, int n_in, void* d_out, int out_size, void* d_ws, size_t ws_size, hipStream_t stream) {
    static int grid = 0;
    if (grid == 0) {
        if (ws_size < WS_END) { fprintf(stderr, "kernel_launch: workspace too small: %zu < %zu\n", ws_size, (size_t)WS_END); grid = -1; return; }
        int dev = 0, cus = 0, per_cu = 0;
        (void)hipGetDevice(&dev);
        (void)hipDeviceGetAttribute(&cus, hipDeviceAttributeMultiprocessorCount, dev);
        if (hipFuncSetAttribute((const void*)mega, hipFuncAttributeMaxDynamicSharedMemorySize, LDS_BYTES) != hipSuccess) fprintf(stderr, "kernel_launch: hipFuncSetAttribute failed\n");
        if (hipOccupancyMaxActiveBlocksPerMultiprocessor(&per_cu, (const void*)mega, NTHREADS, LDS_BYTES) != hipSuccess || per_cu < 1) per_cu = 1;
        (void)hipGetLastError();
        grid = cus * per_cu;
    }
    if (grid < 0) return;
    if (hipMemsetAsync((char*)d_ws + WS_BAR, 0, XCD_BAR_WORDS * 4, stream) != hipSuccess) fprintf(stderr, "kernel_launch: memset of the barrier words failed\n");
    Params p{};
    for (int i = 0; i < 20; ++i) p.in[i] = (const float*)d_in[i];
    p.out = (float*)d_out; p.ws = (unsigned char*)d_ws;
    void* args[] = {&p};
    hipError_t e = hipLaunchCooperativeKernel((const void*)mega, dim3(grid), dim3(NTHREADS), args, LDS_BYTES, stream);
    if (e != hipSuccess) fprintf(stderr, "cooperative launch failed: %s (grid %d)\n", hipGetErrorString(e), grid);
}
```

```cpp
#include <hip/hip_runtime.h>
#include <hip/hip_cooperative_groups.h>
#include <cstdio>
namespace cg = cooperative_groups;

#define LAS __attribute__((address_space(3)))
typedef unsigned short bf16_t;
typedef short bf16x8 __attribute__((ext_vector_type(8)));
typedef float f32x4 __attribute__((ext_vector_type(4)));
typedef float f32x2 __attribute__((ext_vector_type(2)));
typedef unsigned u32x4 __attribute__((ext_vector_type(4)));
typedef unsigned u32x2 __attribute__((ext_vector_type(2)));

#define REP_P0 1
#define REP_SYNC 1
#define REP_GEMM 1
#define REP_MIX 1
#define REP_RES 1
#define GSYNC() do { for (int _r = 0; _r < REP_SYNC; ++_r) xcd_barrier((unsigned*)(pp->ws + WS_BAR), (volatile LAS unsigned*)(lds + LDS_STAGE)); } while (0)

constexpr int D = 2048, MP = 8192, MS = 512, M = MP + MS, FF = 5632;
constexpr float EPS = 1e-6f;
constexpr int NTHREADS = 512, NWAVES = 8;
constexpr int LDS_STAGE = 131072;
constexpr int LDS_BYTES = LDS_STAGE + 16;

constexpr size_t WS_WAIN = 0;
constexpr size_t WS_WAOUT = WS_WAIN + (size_t)6144 * 2048 * 2;
constexpr size_t WS_WBIN = WS_WAOUT + (size_t)2048 * 2048 * 2;
constexpr size_t WS_WBOUT = WS_WBIN + (size_t)4096 * 2048 * 2;
constexpr size_t WS_WGU0 = WS_WBOUT + (size_t)2048 * 2048 * 2;
constexpr size_t WS_WGU1 = WS_WGU0 + (size_t)11264 * 2048 * 2;
constexpr size_t WS_WDN0 = WS_WGU1 + (size_t)11264 * 2048 * 2;
constexpr size_t WS_WDN1 = WS_WDN0 + (size_t)2048 * 5632 * 2;
constexpr size_t WS_H = WS_WDN1 + (size_t)2048 * 5632 * 2;
constexpr size_t WS_BIG = WS_H + (size_t)M * 2048 * 2;
constexpr size_t WS_YIN = WS_BIG + (size_t)M * 5632 * 2;
constexpr size_t WS_MB = WS_YIN + (size_t)M * 2048 * 2;
constexpr size_t WS_STATS = WS_MB + (size_t)M * 2048 * 2;
constexpr size_t WS_XB = WS_STATS + (size_t)M * 64 * 4;
constexpr size_t WS_PART = WS_XB + (size_t)M * 2048 * 2;
constexpr size_t WS_BAR = WS_PART + (size_t)4 * MS * 2048 * 2;
constexpr size_t WS_END = WS_BAR + 3456 * 4;

constexpr size_t O_Y = 0;
constexpr size_t O_SCP = (size_t)M * D;
constexpr size_t O_SCS = O_SCP + 4 * 2 * 2048;
constexpr size_t O_SGU = O_SCS + 32 * 2 * 2048;

struct Params { const float* in[20]; float* out; unsigned char* ws; };
typedef const __attribute__((address_space(4))) Params* PP;
#define FRESH(pp) asm volatile("" : "+s"(pp) :: "memory")

__device__ __forceinline__ unsigned cvt_pk_bf16(float lo, float hi) { unsigned r; asm("v_cvt_pk_bf16_f32 %0, %1, %2" : "=v"(r) : "v"(lo), "v"(hi)); return r; }
__device__ __forceinline__ float bf_lo(unsigned w) { return __uint_as_float(w << 16); }
__device__ __forceinline__ float bf_hi(unsigned w) { return __uint_as_float(w & 0xffff0000u); }
__device__ __forceinline__ float wave_sum(float v) {
#pragma unroll
    for (int o = 1; o < 64; o <<= 1) v += __shfl_xor(v, o);
    return v;
}
__device__ __forceinline__ f32x2 gelu_pk(f32x2 v) {
    const f32x2 av = __builtin_elementwise_abs(v), d = av * 0.2316418882f + 1.0f;
    f32x2 t; t.x = __builtin_amdgcn_rcpf(d.x); t.y = __builtin_amdgcn_rcpf(d.y);
    f32x2 q = t * 0.5307027145f + (-0.7265760135f); q = q * t + 0.7107068705f; q = q * t + (-0.142248368f); q = q * t + 0.127414796f; q = q * t;
    const f32x2 s = (v * v) * (-0.72134752044f);
    f32x2 e; e.x = __builtin_amdgcn_exp2f(s.x); e.y = __builtin_amdgcn_exp2f(s.y);
    const f32x2 h = 0.5f - q * e;
    return v * 0.5f + av * h;
}
__device__ __forceinline__ f32x4 gelu4(f32x4 v) { f32x2 a = gelu_pk((f32x2){v[0], v[1]}), b = gelu_pk((f32x2){v[2], v[3]}); return (f32x4){a.x, a.y, b.x, b.y}; }
__device__ __forceinline__ float silu1(float x) { return x * __builtin_amdgcn_rcpf(1.0f + __builtin_amdgcn_exp2f(-1.4426950408889634f * x)); }
__device__ __forceinline__ f32x4 silu_mul4(f32x4 g, f32x4 u) {
    const f32x4 t = g * (-1.4426950408889634f);
    f32x4 e; e[0] = __builtin_amdgcn_exp2f(t[0]); e[1] = __builtin_amdgcn_exp2f(t[1]); e[2] = __builtin_amdgcn_exp2f(t[2]); e[3] = __builtin_amdgcn_exp2f(t[3]);
    const f32x4 d = e + 1.0f, gu = g * u;
    f32x4 r; r[0] = __builtin_amdgcn_rcpf(d[0]); r[1] = __builtin_amdgcn_rcpf(d[1]); r[2] = __builtin_amdgcn_rcpf(d[2]); r[3] = __builtin_amdgcn_rcpf(d[3]);
    return gu * r;
}

namespace pg8 {
constexpr int BM = 256, BK = 64, HALF = 128, HTB = HALF * BK * 2, NXCD = 8, WGM = 8;
__device__ __forceinline__ int lds_byte(int r, int c) { const int st = (r >> 4) * 2 + (c >> 5), rr = r & 15, cc = c & 31, ob = rr * 64 + cc * 2; return st * 1024 + (ob ^ (((ob >> 9) & 1) << 5)); }
__device__ __forceinline__ void stage_rc(int b, int& R, int& C) { const int st = b / 1024, sb = b % 1024, swz = sb ^ (((sb >> 9) & 1) << 5); R = (st >> 1) * 16 + swz / 64; C = (st & 1) * 32 + (swz % 64) / 2; }
__device__ __forceinline__ int perm32(int rho) { const int n = rho >> 4, i = rho & 15; return 8 * (i >> 2) + 4 * n + (i & 3); }

struct Unit { int pm, pn; };
struct Gemm { const bf16_t* A; const bf16_t* Bt; int M, N, K, ldk, nn; };
struct StaticOrder {
    int nM, nN, nwg, G, c;
    __device__ void init(int M_, int N_, int G_, int c_) { nM = M_ / BM; nN = N_ / BM; nwg = nM * nN; G = G_; c = c_; }
    __device__ bool next(int i, Unit& u) const {
        const long L = (long)i * G + c; if (L >= nwg) return false;
        int wgid = (int)L; { const int q = nwg / NXCD, r = nwg % NXCD, xcd = wgid % NXCD, off = wgid / NXCD; wgid = (xcd < r ? xcd * (q + 1) : r * (q + 1) + (xcd - r) * q) + off; }
        const int nig = WGM * nN, gid = wgid / nig, fm = gid * WGM, gsz = (nM - fm) < WGM ? (nM - fm) : WGM;
        u.pm = fm + ((wgid % nig) % gsz); u.pn = (wgid % nig) / gsz; return true;
    }
};

template <class Epi>
__device__ __forceinline__ void gemm_phase(LAS unsigned char* lds, const Gemm g, const StaticOrder& S, const Epi& E) {
    int tid = threadIdx.x; asm volatile("" : "+v"(tid));
    const int wid = __builtin_amdgcn_readfirstlane(tid >> 6), lane = tid & 63, wr = wid >> 2, wc = wid & 3, fr = lane & 15, fq = lane >> 4;
    const int K = g.K, nt = K / BK;
    unsigned voffA[2], voffB[2];
#pragma unroll
    for (int i = 0; i < 2; ++i) { int R, C; stage_rc(tid * 16 + i * 8192, R, C); const int Rb = (R & ~31) + perm32(R & 31);
        voffA[i] = (unsigned)(R * g.ldk + C) * 2u; voffB[i] = (unsigned)(Rb * g.ldk + C) * 2u; }
    const size_t kstep = (size_t)(BK * 2);
    const size_t hstep = (size_t)HALF * g.ldk * 2;
    const size_t tstep = 2 * hstep;
    const unsigned ldsw = (unsigned)wid * 1024u;
    const int aoff = lds_byte(wr * 64 + fr, fq * 8), boff = lds_byte(wc * 32 + fr, fq * 8);
#define PG8_SA(b, h) (((b) * 2 + (h)) * HTB)
#define PG8_SB(b, h) ((4 + (b) * 2 + (h)) * HTB)
#define PG8_STAGE(bufoff, gbase, voff) do { _Pragma("unroll") for (int _i = 0; _i < 2; ++_i) \
        __builtin_amdgcn_global_load_lds((const unsigned*)((const char*)(gbase) + (voff)[_i]), (LAS unsigned*)(lds + (bufoff) + ldsw + _i * 8192), 16, 0, 0); } while (0)
#define PG8_LDA(dst, b, h) do { _Pragma("unroll") for (int m = 0; m < 4; ++m) _Pragma("unroll") for (int k = 0; k < 2; ++k) dst[m][k] = *(const LAS bf16x8*)(lds + PG8_SA(b, h) + aoff + m * 2048 + k * 1024); } while (0)
#define PG8_LDB(dst, b, h) do { _Pragma("unroll") for (int n = 0; n < 2; ++n) _Pragma("unroll") for (int k = 0; k < 2; ++k) dst[n][k] = *(const LAS bf16x8*)(lds + PG8_SB(b, h) + boff + n * 2048 + k * 1024); } while (0)
#define PG8_MMA(ai, bj, At, Bt) do { __builtin_amdgcn_s_setprio(3); _Pragma("unroll") for (int m = 0; m < 4; ++m) _Pragma("unroll") for (int n = 0; n < 2; ++n) _Pragma("unroll") for (int k = 0; k < 2; ++k) \
        acc[ai][bj][m][n] = __builtin_amdgcn_mfma_f32_16x16x32_bf16(Bt[n][k], At[m][k], acc[ai][bj][m][n], 0, 0, 0); __builtin_amdgcn_s_setprio(0); } while (0)
#define PG8_WAIT_V(n) asm volatile("s_waitcnt vmcnt(" #n ")" ::: "memory")
#define PG8_WAIT_L(n) asm volatile("s_waitcnt lgkmcnt(" #n ")" ::: "memory")
#define PG8_BAR __builtin_amdgcn_s_barrier()
#define PG8_SCHED __builtin_amdgcn_sched_barrier(0)
    Unit cur, nxt; int ui = 0;
    if (!S.next(0, cur)) return;
    f32x4 acc[2][2][4][2];
#pragma unroll
    for (int a = 0; a < 2; ++a)
#pragma unroll
        for (int b = 0; b < 2; ++b)
#pragma unroll
            for (int m = 0; m < 4; ++m)
#pragma unroll
                for (int n = 0; n < 2; ++n) acc[a][b][m][n] = (f32x4){0.f, 0.f, 0.f, 0.f};
    bf16x8 At[4][2], B0[2][2], B1[2][2];
    const size_t pstep = (size_t)K * 2;
    const char* cA = (const char*)g.A + (size_t)cur.pm * tstep + (size_t)(cur.pn / g.nn) * pstep; const char* cB = (const char*)g.Bt + (size_t)(cur.pn % g.nn) * tstep + (size_t)(cur.pn / g.nn) * pstep;
    PG8_STAGE(PG8_SB(0, 0), cB, voffB); PG8_STAGE(PG8_SA(0, 0), cA, voffA); PG8_STAGE(PG8_SB(0, 1), cB + hstep, voffB); PG8_STAGE(PG8_SA(0, 1), cA + hstep, voffA);
    if (wr == 1) PG8_BAR;
    PG8_WAIT_V(4); PG8_BAR;
    PG8_STAGE(PG8_SB(1, 0), cB + kstep, voffB); PG8_STAGE(PG8_SA(1, 0), cA + kstep, voffA); PG8_STAGE(PG8_SB(1, 1), cB + hstep + kstep, voffB);
    PG8_WAIT_V(6); PG8_BAR;
    for (;;) {
        const bool has_next = S.next(ui + 1, nxt);
        const char* nA = has_next ? (const char*)g.A + (size_t)nxt.pm * tstep + (size_t)(nxt.pn / g.nn) * pstep : cA; const char* nB = has_next ? (const char*)g.Bt + (size_t)(nxt.pn % g.nn) * tstep + (size_t)(nxt.pn / g.nn) * pstep : cB;
        asm volatile(".p2align 8");
        for (int t = 0; t < nt; t += 2) {
            const bool last = (t == nt - 2);
            const char* a1 = cA + (size_t)(t + 1) * kstep;
            const char* a2 = last ? nA : cA + (size_t)(t + 2) * kstep; const char* b2 = last ? nB : cB + (size_t)(t + 2) * kstep;
            const char* a3 = a2 + kstep; const char* b3 = b2 + kstep;
            PG8_LDB(B0, 0, 0); PG8_SCHED; PG8_LDA(At, 0, 0); PG8_STAGE(PG8_SA(1, 1), a1 + hstep, voffA);
            PG8_WAIT_L(8); PG8_BAR; PG8_WAIT_L(0); PG8_MMA(0, 0, At, B0); PG8_BAR; PG8_SCHED;
            PG8_LDB(B1, 0, 1); PG8_STAGE(PG8_SB(0, 0), b2, voffB);
            PG8_BAR; PG8_WAIT_L(0); PG8_MMA(0, 1, At, B1); PG8_BAR;
            PG8_LDA(At, 0, 1); PG8_STAGE(PG8_SA(0, 0), a2, voffA);
            PG8_BAR; PG8_WAIT_L(0); PG8_MMA(1, 0, At, B0); PG8_BAR; PG8_SCHED;
            PG8_STAGE(PG8_SB(0, 1), b2 + hstep, voffB);
            PG8_WAIT_V(6); PG8_BAR; PG8_MMA(1, 1, At, B1); PG8_BAR;
            PG8_LDB(B0, 1, 0); PG8_SCHED; PG8_LDA(At, 1, 0); PG8_STAGE(PG8_SA(0, 1), a2 + hstep, voffA);
            PG8_WAIT_L(8); PG8_BAR; PG8_WAIT_L(0); PG8_MMA(0, 0, At, B0); PG8_BAR; PG8_SCHED;
            PG8_LDB(B1, 1, 1); PG8_STAGE(PG8_SB(1, 0), b3, voffB);
            PG8_BAR; PG8_WAIT_L(0); PG8_MMA(0, 1, At, B1); PG8_BAR;
            PG8_LDA(At, 1, 1); PG8_STAGE(PG8_SA(1, 0), a3, voffA);
            PG8_BAR; PG8_WAIT_L(0); PG8_MMA(1, 0, At, B0); PG8_BAR; PG8_SCHED;
            PG8_STAGE(PG8_SB(1, 1), b3 + hstep, voffB);
            PG8_WAIT_V(6); PG8_BAR; PG8_MMA(1, 1, At, B1); PG8_BAR;
        }
        E(acc, cur, wr, wc, fr, fq);
        if (!has_next) break;
#pragma unroll
        for (int a = 0; a < 2; ++a)
#pragma unroll
            for (int b = 0; b < 2; ++b)
#pragma unroll
                for (int m = 0; m < 4; ++m)
#pragma unroll
                    for (int n = 0; n < 2; ++n) acc[a][b][m][n] = (f32x4){0.f, 0.f, 0.f, 0.f};
        cur = nxt; cA = nA; cB = nB; ++ui;
    }
    PG8_WAIT_V(0);
    if (wr == 0) PG8_BAR;
    PG8_BAR;
#undef PG8_SA
#undef PG8_SB
#undef PG8_STAGE
#undef PG8_LDA
#undef PG8_LDB
#undef PG8_MMA
#undef PG8_WAIT_V
#undef PG8_WAIT_L
#undef PG8_BAR
#undef PG8_SCHED
}
}
using pg8::Unit;

__device__ __forceinline__ u32x4 pack8(f32x4 v0, f32x4 v1) { u32x4 w; w.x = cvt_pk_bf16(v0[0], v0[1]); w.y = cvt_pk_bf16(v0[2], v0[3]); w.z = cvt_pk_bf16(v1[0], v1[1]); w.w = cvt_pk_bf16(v1[2], v1[3]); return w; }

struct EpiPlain {
    bf16_t* O0; bf16_t* O1; bf16_t* O2; bf16_t* O3; int ldc, nn;
    __device__ __forceinline__ void operator()(const f32x4 (&acc)[2][2][4][2], const Unit& u, int wr, int wc, int fr, int fq) const {
        const int kh = u.pn / nn, pn = u.pn - kh * nn; bf16_t* O = kh == 0 ? O0 : (kh == 1 ? O1 : (kh == 2 ? O2 : O3));
        const int row0 = u.pm * 256 + wr * 64 + fr, col0 = pn * 256 + wc * 32 + 8 * fq;
#pragma unroll
        for (int ai = 0; ai < 2; ++ai)
#pragma unroll
            for (int m = 0; m < 4; ++m) { bf16_t* rowp = O + (size_t)(row0 + ai * 128 + m * 16) * ldc + col0;
#pragma unroll
                for (int bj = 0; bj < 2; ++bj) *(u32x4*)(rowp + bj * 128) = pack8(acc[ai][bj][m][0], acc[ai][bj][m][1]); }
    }
};
struct EpiGU {
    bf16_t* O;
    __device__ __forceinline__ void operator()(const f32x4 (&acc)[2][2][4][2], const Unit& u, int wr, int wc, int fr, int fq) const {
        const int row0 = u.pm * 256 + wr * 64 + fr, col0 = u.pn * 128 + wc * 32 + 8 * fq;
#pragma unroll
        for (int ai = 0; ai < 2; ++ai)
#pragma unroll
            for (int m = 0; m < 4; ++m) { bf16_t* rowp = O + (size_t)(row0 + ai * 128 + m * 16) * FF + col0;
                const f32x4 o0 = silu_mul4(acc[ai][0][m][0], acc[ai][1][m][0]), o1 = silu_mul4(acc[ai][0][m][1], acc[ai][1][m][1]);
                *(u32x4*)rowp = pack8(o0, o1); }
    }
};
struct EpiCZ {
    bf16_t* GB; bf16_t* CZ; float* scp; float* scs;
    __device__ __forceinline__ void operator()(const f32x4 (&acc)[2][2][4][2], const Unit& u, int wr, int wc, int fr, int fq) const {
        const int row0 = u.pm * 256 + wr * 64 + fr;
        if (u.pn < 16) {
            const int col0 = u.pn * 128 + wc * 32 + 8 * fq;
#pragma unroll
            for (int ai = 0; ai < 2; ++ai)
#pragma unroll
                for (int m = 0; m < 4; ++m) { const int r = row0 + ai * 128 + m * 16;
                    const f32x4 c0 = acc[ai][0][m][0] * acc[ai][1][m][0], c1 = acc[ai][0][m][1] * acc[ai][1][m][1];
                    *(u32x4*)(CZ + (size_t)r * D + col0) = pack8(c0, c1);
                    float* sp = nullptr;
                    if (r < MP) { const int t = r & 2047; if (t >= 2046) sp = scp + (size_t)((r >> 11) * 2 + (t - 2046)) * D; }
                    else { const int t = r & 15; if (t >= 14) sp = scs + (size_t)(((r - MP) >> 4) * 2 + (t - 14)) * D; }
                    if (sp) { *(f32x4*)(sp + col0) = c0; *(f32x4*)(sp + col0 + 4) = c1; } }
        } else {
            const int col0 = (u.pn - 16) * 256 + wc * 32 + 8 * fq;
#pragma unroll
            for (int ai = 0; ai < 2; ++ai)
#pragma unroll
                for (int m = 0; m < 4; ++m) { bf16_t* rowp = GB + (size_t)(row0 + ai * 128 + m * 16) * D + col0;
#pragma unroll
                    for (int bj = 0; bj < 2; ++bj) *(u32x4*)(rowp + bj * 128) = pack8(acc[ai][bj][m][0], acc[ai][bj][m][1]); }
        }
    }
};
struct EpiGelu {
    bf16_t* O; const float* bias; float* stats;
    __device__ __forceinline__ void operator()(const f32x4 (&acc)[2][2][4][2], const Unit& u, int wr, int wc, int fr, int fq) const {
        const int row0 = u.pm * 256 + wr * 64 + fr, col0 = u.pn * 256 + wc * 32 + 8 * fq;
        f32x4 bv[2][2];
#pragma unroll
        for (int bj = 0; bj < 2; ++bj)
#pragma unroll
            for (int n = 0; n < 2; ++n) bv[bj][n] = *(const f32x4*)(bias + col0 + bj * 128 + 4 * n);
#pragma unroll
        for (int ai = 0; ai < 2; ++ai)
#pragma unroll
            for (int m = 0; m < 4; ++m) { const int r = row0 + ai * 128 + m * 16; bf16_t* rowp = O + (size_t)r * 4096 + col0; float s = 0.f, ss = 0.f;
#pragma unroll
                for (int bj = 0; bj < 2; ++bj) { const f32x4 v0 = gelu4(acc[ai][bj][m][0] + bv[bj][0]), v1 = gelu4(acc[ai][bj][m][1] + bv[bj][1]);
                    s += (v0[0] + v0[1]) + (v0[2] + v0[3]) + (v1[0] + v1[1]) + (v1[2] + v1[3]);
                    ss += (v0[0] * v0[0] + v0[1] * v0[1]) + (v0[2] * v0[2] + v0[3] * v0[3]) + (v1[0] * v1[0] + v1[1] * v1[1]) + (v1[2] * v1[2] + v1[3] * v1[3]);
                    *(u32x4*)(rowp + bj * 128) = pack8(v0, v1); }
                if (u.pn >= 8) { s += __shfl_xor(s, 16); s += __shfl_xor(s, 32); ss += __shfl_xor(ss, 16); ss += __shfl_xor(ss, 32);
                    if (fq == 0) *(f32x2*)(stats + ((size_t)r * 32 + (u.pn - 8) * 4 + wc) * 2) = (f32x2){s, ss}; } }
    }
};

__device__ __forceinline__ void transpose_item(const float* W, int K, int N, bf16_t* WT, int mode, LAS float* scr, int item, int lane) {
    const int nblk = N / 32, kb = item / nblk, nb = item % nblk, k0 = 64 * kb, n0 = 32 * nb;
    int row0;
    if (mode == 0) row0 = n0;
    else if (mode == 1) row0 = 256 * (n0 >> 7) + (n0 & 127);
    else if (mode == 2) row0 = 256 * (n0 >> 7) + 128 + (n0 & 127);
    else { const int part = n0 >> 11, c = n0 & 2047; row0 = part == 0 ? 4096 + c : (256 * (c >> 7) + (part == 2 ? 128 : 0) + (c & 127)); }
#pragma unroll 8
    for (int i = 0; i < 32; ++i) { const int kk = 2 * i + (lane >> 5); scr[kk * 33 + (lane & 31)] = __builtin_nontemporal_load(W + (size_t)(k0 + kk) * N + n0 + (lane & 31)); }
    asm volatile("s_waitcnt lgkmcnt(0)" ::: "memory");
    const int c = lane & 7;
#pragma unroll
    for (int j = 0; j < 4; ++j) { const int n = (lane >> 3) + 8 * j; const LAS float* s = scr + (8 * c) * 33 + n;
        u32x4 o; o.x = cvt_pk_bf16(s[0 * 33], s[1 * 33]); o.y = cvt_pk_bf16(s[2 * 33], s[3 * 33]); o.z = cvt_pk_bf16(s[4 * 33], s[5 * 33]); o.w = cvt_pk_bf16(s[6 * 33], s[7 * 33]);
        __builtin_nontemporal_store(o, (u32x4*)(WT + (size_t)(row0 + n) * K + k0 + 8 * c)); }
    asm volatile("s_waitcnt lgkmcnt(0)" ::: "memory");
}

constexpr int I_AIN = 32 * 192, I_SQ = 32 * 64, I_BIN = 32 * 128, I_GU = 32 * 176, I_DN = 88 * 64;
constexpr int CV_P0 = I_AIN + I_SQ, CV_T1 = CV_P0 + 2 * I_GU, CV_T3 = CV_T1 + I_DN + I_BIN + I_SQ, CV_T8 = CV_T3 + 2 * I_GU, CV_T10 = CV_T8 + I_DN;
__device__ __forceinline__ void convert_items(PP pp, LAS unsigned char* lds, int lo, int hi, int w, int nw, int wave, int lane) {
    LAS float* scr = (LAS float*)(lds + wave * 8448);
    unsigned char* ws = pp->ws;
    for (int it = lo + w; it < hi; it += nw) {
        int r = it;
        if (r < I_AIN) { transpose_item(pp->in[7], D, 3 * D, (bf16_t*)(ws + WS_WAIN), 3, scr, r, lane); continue; } r -= I_AIN;
        if (r < I_SQ) { transpose_item(pp->in[9], D, D, (bf16_t*)(ws + WS_WAOUT), 0, scr, r, lane); continue; } r -= I_SQ;
        if (r < I_GU) { transpose_item(pp->in[17], D, FF, (bf16_t*)(ws + WS_WGU0), 1, scr, r, lane); continue; } r -= I_GU;
        if (r < I_GU) { transpose_item(pp->in[18], D, FF, (bf16_t*)(ws + WS_WGU0), 2, scr, r, lane); continue; } r -= I_GU;
        if (r < I_DN) { transpose_item(pp->in[19], FF, D, (bf16_t*)(ws + WS_WDN0), 0, scr, r, lane); continue; } r -= I_DN;
        if (r < I_BIN) { transpose_item(pp->in[10], D, 2 * D, (bf16_t*)(ws + WS_WBIN), 0, scr, r, lane); continue; } r -= I_BIN;
        if (r < I_SQ) { transpose_item(pp->in[16], D, D, (bf16_t*)(ws + WS_WBOUT), 0, scr, r, lane); continue; } r -= I_SQ;
        if (r < I_GU) { transpose_item(pp->in[17] + (size_t)D * FF, D, FF, (bf16_t*)(ws + WS_WGU1), 1, scr, r, lane); continue; } r -= I_GU;
        if (r < I_GU) { transpose_item(pp->in[18] + (size_t)D * FF, D, FF, (bf16_t*)(ws + WS_WGU1), 2, scr, r, lane); continue; } r -= I_GU;
        transpose_item(pp->in[19] + (size_t)FF * D, FF, D, (bf16_t*)(ws + WS_WDN1), 0, scr, r, lane);
    }
}
__device__ __forceinline__ void tail_convert(PP pp, LAS unsigned char* lds, int nwg, int G, int lo, int hi) {
    const int rem = nwg % G;
    if ((int)blockIdx.x < rem || lo >= hi) return;
    int tid = threadIdx.x; asm volatile("" : "+v"(tid));
    const int wave = __builtin_amdgcn_readfirstlane(tid >> 6), lane = tid & 63;
    convert_items(pp, lds, lo, hi, ((int)blockIdx.x - rem) * NWAVES + wave, (G - rem) * NWAVES, wave, lane);
}

__device__ __forceinline__ void phase0(PP pp, LAS unsigned char* lds, int gw, int NGW, int wave, int lane) {
    unsigned char* ws = pp->ws;
    convert_items(pp, lds, 0, CV_P0, gw, NGW, wave, lane);
    bf16_t* H = (bf16_t*)(ws + WS_H);
    const float* gpre = pp->in[3];
    for (int row = gw; row < M; row += 2 * NGW) {
        const int rowB = row + NGW; const bool hasB = rowB < M;
        const float* xa = row < MP ? pp->in[0] + (size_t)row * D : pp->in[1] + (size_t)(row - MP) * D;
        const float* xbp = !hasB ? xa : (rowB < MP ? pp->in[0] + (size_t)rowB * D : pp->in[1] + (size_t)(rowB - MP) * D);
        f32x4 va[4][2], vb[4][2]; float sa = 0.f, sb = 0.f;
#pragma unroll
        for (int j = 0; j < 4; ++j)
#pragma unroll
            for (int h = 0; h < 2; ++h) va[j][h] = __builtin_nontemporal_load((const f32x4*)(xa + 512 * j + 8 * lane + 4 * h));
#pragma unroll
        for (int j = 0; j < 4; ++j)
#pragma unroll
            for (int h = 0; h < 2; ++h) vb[j][h] = __builtin_nontemporal_load((const f32x4*)(xbp + 512 * j + 8 * lane + 4 * h));
#pragma unroll
        for (int j = 0; j < 4; ++j)
#pragma unroll
            for (int h = 0; h < 2; ++h) { const f32x4 v = va[j][h]; sa += (v[0] * v[0] + v[1] * v[1]) + (v[2] * v[2] + v[3] * v[3]); const f32x4 w = vb[j][h]; sb += (w[0] * w[0] + w[1] * w[1]) + (w[2] * w[2] + w[3] * w[3]); }
        const float ra = 1.0f / sqrtf(wave_sum(sa) * (1.0f / D) + EPS), rb = 1.0f / sqrtf(wave_sum(sb) * (1.0f / D) + EPS);
#pragma unroll
        for (int j = 0; j < 4; ++j) { const f32x4 g0 = *(const f32x4*)(gpre + 512 * j + 8 * lane), g1 = *(const f32x4*)(gpre + 512 * j + 8 * lane + 4);
            *(u32x4*)(H + (size_t)row * D + 512 * j + 8 * lane) = pack8(va[j][0] * ra * g0, va[j][1] * ra * g1);
            if (hasB) *(u32x4*)(H + (size_t)rowB * D + 512 * j + 8 * lane) = pack8(vb[j][0] * rb * g0, vb[j][1] * rb * g1); }
    }
}

__device__ __forceinline__ void unpack8(u32x4 w, float (&f)[8]) { f[0] = bf_lo(w.x); f[1] = bf_hi(w.x); f[2] = bf_lo(w.y); f[3] = bf_hi(w.y); f[4] = bf_lo(w.z); f[5] = bf_hi(w.z); f[6] = bf_lo(w.w); f[7] = bf_hi(w.w); }
__device__ __forceinline__ void conv_hist(const float* cache, int s0, int hi, int c, float (&p)[8]) {
    if (s0 < MP) {
#pragma unroll
        for (int e = 0; e < 8; ++e) p[e] = 0.f;
    } else { const float* hp = cache + (size_t)(((s0 - MP) >> 4) * 2 + hi) * D + c; const f32x4 a = *(const f32x4*)hp, b = *(const f32x4*)(hp + 4);
        p[0] = a[0]; p[1] = a[1]; p[2] = a[2]; p[3] = a[3]; p[4] = b[0]; p[5] = b[1]; p[6] = b[2]; p[7] = b[3]; }
}
__device__ __forceinline__ void conv_phase(PP pp, int G) {
    unsigned char* ws = pp->ws;
    const bf16_t* GB = (const bf16_t*)(ws + WS_BIG); const bf16_t* CZ = GB + (size_t)M * D; bf16_t* YIN = (bf16_t*)(ws + WS_YIN);
    const float* cw = pp->in[8]; const float* cache = pp->in[2];
    int tid = threadIdx.x; asm volatile("" : "+v"(tid));
    constexpr int R = 17; static_assert(M % R == 0, "row blocks");
    for (int item = blockIdx.x * NTHREADS + tid; item < (M / R) * 256; item += G * NTHREADS) {
        const int cb = item & 255, rb = item >> 8, r0 = rb * R, c = cb * 8;
        float w0[8], w1[8], w2[8], p2[8], p1[8];
#pragma unroll
        for (int e = 0; e < 8; ++e) { w0[e] = cw[c + e]; w1[e] = cw[D + c + e]; w2[e] = cw[2 * D + c + e]; }
        { const int s0 = r0 < MP ? (r0 & ~2047) : MP + ((r0 - MP) & ~15);
          if (r0 - 2 >= s0) unpack8(*(const u32x4*)(CZ + (size_t)(r0 - 2) * D + c), p2); else conv_hist(cache, s0, r0 - s0, c, p2);
          if (r0 - 1 >= s0) unpack8(*(const u32x4*)(CZ + (size_t)(r0 - 1) * D + c), p1); else conv_hist(cache, s0, 1, c, p1); }
#pragma unroll
        for (int ch = 0; ch < 2; ++ch) { constexpr int CH = 9; const int i0 = ch * CH, i1 = ch ? R : CH;
            u32x4 czr[CH], gbr[CH];
#pragma unroll
            for (int i = i0; i < i1; ++i) { const size_t off = (size_t)(r0 + i) * D + c; czr[i - i0] = __builtin_nontemporal_load((const u32x4*)(CZ + off)); gbr[i - i0] = __builtin_nontemporal_load((const u32x4*)(GB + off)); }
#pragma unroll
            for (int i = i0; i < i1; ++i) { const int r = r0 + i; const size_t off = (size_t)r * D + c; float cu[8], gb[8], y[8];
                if (i > 0) { const bool start = r < MP ? ((r & 2047) == 0) : (((r - MP) & 15) == 0); if (start) { conv_hist(cache, r, 0, c, p2); conv_hist(cache, r, 1, c, p1); } }
                unpack8(czr[i - i0], cu); unpack8(gbr[i - i0], gb);
#pragma unroll
                for (int e = 0; e < 8; ++e) { y[e] = gb[e] * (w0[e] * p2[e] + w1[e] * p1[e] + w2[e] * cu[e]); p2[e] = p1[e]; p1[e] = cu[e]; }
                u32x4 o; o.x = cvt_pk_bf16(y[0], y[1]); o.y = cvt_pk_bf16(y[2], y[3]); o.z = cvt_pk_bf16(y[4], y[5]); o.w = cvt_pk_bf16(y[6], y[7]);
                *(u32x4*)(YIN + off) = o; } }
    }
}

struct RnRow { f32x4 xf[4][2]; u32x4 xr[4]; u32x4 mr[4]; };
__device__ __forceinline__ void rn_load(RnRow& R, int row, const float* xp, const bf16_t* xb, const bf16_t* mb, int lane) {
    if (xp) {
#pragma unroll
        for (int j = 0; j < 4; ++j) { R.xf[j][0] = __builtin_nontemporal_load((const f32x4*)(xp + (size_t)row * D + 512 * j + 8 * lane)); R.xf[j][1] = __builtin_nontemporal_load((const f32x4*)(xp + (size_t)row * D + 512 * j + 8 * lane + 4)); }
    } else {
#pragma unroll
        for (int j = 0; j < 4; ++j) R.xr[j] = __builtin_nontemporal_load((const u32x4*)(xb + (size_t)row * D + 512 * j + 8 * lane));
    }
#pragma unroll
    for (int j = 0; j < 4; ++j) R.mr[j] = __builtin_nontemporal_load((const u32x4*)(mb + (size_t)row * D + 512 * j + 8 * lane));
}
__device__ __forceinline__ void rn_finish(RnRow& R, int row, bool from_f32, bf16_t* xb, float* xout, const float* gpost, const float* gnext, bf16_t* H, int lane) {
    float mf[4][8]; f32x4 xv[4][2]; float ss = 0.f;
#pragma unroll
    for (int j = 0; j < 4; ++j) {
        if (from_f32) { xv[j][0] = R.xf[j][0]; xv[j][1] = R.xf[j][1]; }
        else { float t[8]; unpack8(R.xr[j], t); xv[j][0] = (f32x4){t[0], t[1], t[2], t[3]}; xv[j][1] = (f32x4){t[4], t[5], t[6], t[7]}; }
        unpack8(R.mr[j], mf[j]);
#pragma unroll
        for (int e = 0; e < 8; ++e) ss += mf[j][e] * mf[j][e]; }
    const float r = 1.0f / sqrtf(wave_sum(ss) * (1.0f / D) + EPS);
    float ss2 = 0.f;
#pragma unroll
    for (int j = 0; j < 4; ++j) { const f32x4 g0 = *(const f32x4*)(gpost + 512 * j + 8 * lane), g1 = *(const f32x4*)(gpost + 512 * j + 8 * lane + 4);
        const f32x4 m0 = (f32x4){mf[j][0], mf[j][1], mf[j][2], mf[j][3]}, m1 = (f32x4){mf[j][4], mf[j][5], mf[j][6], mf[j][7]};
        xv[j][0] = xv[j][0] + m0 * r * g0; xv[j][1] = xv[j][1] + m1 * r * g1;
#pragma unroll
        for (int h = 0; h < 2; ++h) { const f32x4 v = xv[j][h]; ss2 += (v[0] * v[0] + v[1] * v[1]) + (v[2] * v[2] + v[3] * v[3]); }
        if (gnext) *(u32x4*)(xb + (size_t)row * D + 512 * j + 8 * lane) = pack8(xv[j][0], xv[j][1]);
        else { *(f32x4*)(xout + (size_t)row * D + 512 * j + 8 * lane) = xv[j][0]; *(f32x4*)(xout + (size_t)row * D + 512 * j + 8 * lane + 4) = xv[j][1]; } }
    if (gnext) {
        const float r2 = 1.0f / sqrtf(wave_sum(ss2) * (1.0f / D) + EPS);
#pragma unroll
        for (int j = 0; j < 4; ++j) { const f32x4 g0 = *(const f32x4*)(gnext + 512 * j + 8 * lane), g1 = *(const f32x4*)(gnext + 512 * j + 8 * lane + 4);
            *(u32x4*)(H + (size_t)row * D + 512 * j + 8 * lane) = pack8(xv[j][0] * r2 * g0, xv[j][1] * r2 * g1); }
    }
}
__device__ __forceinline__ void resnorm_phase(const float* xp, const float* xs, bf16_t* xb, float* xout, const bf16_t* mb, const bf16_t* part, const float* gpost, const float* gnext, bf16_t* H, int gw, int NGW, int lane, LAS unsigned char* lds) {
    const bool quarter = (NGW == 4 * MS);
    if (quarter) {
        for (int row = gw; row < MP; row += 2 * NGW) { RnRow A, B;
            rn_load(A, row, xp, xb, mb, lane); rn_load(B, row + NGW, xp, xb, mb, lane);
            rn_finish(A, row, xp != nullptr, xb, xout, gpost, gnext, H, lane); rn_finish(B, row + NGW, xp != nullptr, xb, xout, gpost, gnext, H, lane); }
    }
    for (int row = gw; row < (quarter ? 0 : M); row += NGW) {
        float mf[4][8]; f32x4 xv[4][2]; float ss = 0.f;
        if (xp) { const float* xr = row < MP ? xp + (size_t)row * D : xs + (size_t)(row - MP) * D;
#pragma unroll
            for (int j = 0; j < 4; ++j) { xv[j][0] = *(const f32x4*)(xr + 512 * j + 8 * lane); xv[j][1] = *(const f32x4*)(xr + 512 * j + 8 * lane + 4); }
        } else {
#pragma unroll
            for (int j = 0; j < 4; ++j) { float t[8]; unpack8(__builtin_nontemporal_load((const u32x4*)(xb + (size_t)row * D + 512 * j + 8 * lane)), t); xv[j][0] = (f32x4){t[0], t[1], t[2], t[3]}; xv[j][1] = (f32x4){t[4], t[5], t[6], t[7]}; }
        }
#pragma unroll
        for (int j = 0; j < 4; ++j) {
            if (part && row >= MP) { const size_t o = (size_t)(row - MP) * D + 512 * j + 8 * lane; float p1[8], p2[8], p3[8];
                unpack8(__builtin_nontemporal_load((const u32x4*)(part + o)), mf[j]); unpack8(__builtin_nontemporal_load((const u32x4*)(part + (size_t)MS * D + o)), p1);
                unpack8(__builtin_nontemporal_load((const u32x4*)(part + (size_t)2 * MS * D + o)), p2); unpack8(__builtin_nontemporal_load((const u32x4*)(part + (size_t)3 * MS * D + o)), p3);
#pragma unroll
                for (int e = 0; e < 8; ++e) mf[j][e] = (mf[j][e] + p1[e]) + (p2[e] + p3[e]);
            } else unpack8(__builtin_nontemporal_load((const u32x4*)(mb + (size_t)row * D + 512 * j + 8 * lane)), mf[j]);
#pragma unroll
            for (int e = 0; e < 8; ++e) ss += mf[j][e] * mf[j][e]; }
        const float r = 1.0f / sqrtf(wave_sum(ss) * (1.0f / D) + EPS);
        float ss2 = 0.f;
#pragma unroll
        for (int j = 0; j < 4; ++j) { const f32x4 g0 = *(const f32x4*)(gpost + 512 * j + 8 * lane), g1 = *(const f32x4*)(gpost + 512 * j + 8 * lane + 4);
            const f32x4 m0 = (f32x4){mf[j][0], mf[j][1], mf[j][2], mf[j][3]}, m1 = (f32x4){mf[j][4], mf[j][5], mf[j][6], mf[j][7]};
            xv[j][0] = xv[j][0] + m0 * r * g0; xv[j][1] = xv[j][1] + m1 * r * g1;
#pragma unroll
            for (int h = 0; h < 2; ++h) { const f32x4 v = xv[j][h]; ss2 += (v[0] * v[0] + v[1] * v[1]) + (v[2] * v[2] + v[3] * v[3]); }
            if (gnext) *(u32x4*)(xb + (size_t)row * D + 512 * j + 8 * lane) = pack8(xv[j][0], xv[j][1]);
            else { *(f32x4*)(xout + (size_t)row * D + 512 * j + 8 * lane) = xv[j][0]; *(f32x4*)(xout + (size_t)row * D + 512 * j + 8 * lane + 4) = xv[j][1]; } }
        if (gnext) {
            const float r2 = 1.0f / sqrtf(wave_sum(ss2) * (1.0f / D) + EPS);
#pragma unroll
            for (int j = 0; j < 4; ++j) { const f32x4 g0 = *(const f32x4*)(gnext + 512 * j + 8 * lane), g1 = *(const f32x4*)(gnext + 512 * j + 8 * lane + 4);
                *(u32x4*)(H + (size_t)row * D + 512 * j + 8 * lane) = pack8(xv[j][0] * r2 * g0, xv[j][1] * r2 * g1); }
        }
    }
    if (quarter) {
        const int wave = (gw & 7), q = wave & 3, row = MP + (gw >> 2); const size_t off = (size_t)row * D + 512 * q + 8 * lane;
        LAS float* red = (LAS float*)lds;
        float t[8], mf[8];
        if (xp) { const float* xr = xs + (size_t)(row - MP) * D + 512 * q + 8 * lane; const f32x4 a = *(const f32x4*)xr, b = *(const f32x4*)(xr + 4); t[0] = a[0]; t[1] = a[1]; t[2] = a[2]; t[3] = a[3]; t[4] = b[0]; t[5] = b[1]; t[6] = b[2]; t[7] = b[3]; }
        else unpack8(__builtin_nontemporal_load((const u32x4*)(xb + off)), t);
        if (part) { const size_t o = off - (size_t)MP * D; float p1[8], p2[8], p3[8];
            unpack8(__builtin_nontemporal_load((const u32x4*)(part + o)), mf); unpack8(__builtin_nontemporal_load((const u32x4*)(part + (size_t)MS * D + o)), p1);
            unpack8(__builtin_nontemporal_load((const u32x4*)(part + (size_t)2 * MS * D + o)), p2); unpack8(__builtin_nontemporal_load((const u32x4*)(part + (size_t)3 * MS * D + o)), p3);
#pragma unroll
            for (int e = 0; e < 8; ++e) mf[e] = (mf[e] + p1[e]) + (p2[e] + p3[e]);
        } else unpack8(__builtin_nontemporal_load((const u32x4*)(mb + off)), mf);
        float ss = 0.f;
#pragma unroll
        for (int e = 0; e < 8; ++e) ss += mf[e] * mf[e];
        ss = wave_sum(ss);
        __syncthreads();
        if (lane == 0) red[wave] = ss;
        __syncthreads();
        const int w4 = wave & 4;
        const float r = 1.0f / sqrtf(((red[w4] + red[w4 + 1]) + (red[w4 + 2] + red[w4 + 3])) * (1.0f / D) + EPS);
        const f32x4 g0 = *(const f32x4*)(gpost + 512 * q + 8 * lane), g1 = *(const f32x4*)(gpost + 512 * q + 8 * lane + 4);
        f32x4 x0 = (f32x4){t[0], t[1], t[2], t[3]} + (f32x4){mf[0], mf[1], mf[2], mf[3]} * r * g0, x1 = (f32x4){t[4], t[5], t[6], t[7]} + (f32x4){mf[4], mf[5], mf[6], mf[7]} * r * g1;
        if (gnext) {
            *(u32x4*)(xb + off) = pack8(x0, x1);
            float ss2 = (x0[0] * x0[0] + x0[1] * x0[1]) + (x0[2] * x0[2] + x0[3] * x0[3]) + (x1[0] * x1[0] + x1[1] * x1[1]) + (x1[2] * x1[2] + x1[3] * x1[3]);
            ss2 = wave_sum(ss2);
            if (lane == 0) red[8 + wave] = ss2;
            __syncthreads();
            const float r2 = 1.0f / sqrtf(((red[8 + w4] + red[9 + w4]) + (red[10 + w4] + red[11 + w4])) * (1.0f / D) + EPS);
            const f32x4 n0 = *(const f32x4*)(gnext + 512 * q + 8 * lane), n1 = *(const f32x4*)(gnext + 512 * q + 8 * lane + 4);
            *(u32x4*)(H + off) = pack8(x0 * r2 * n0, x1 * r2 * n1);
        } else { *(f32x4*)(xout + off) = x0; *(f32x4*)(xout + off + 4) = x1; }
    }
}

__device__ __forceinline__ void sgu_phase(PP pp, LAS unsigned char* lds, int G) {
    unsigned char* ws = pp->ws;
    LAS bf16_t* Aw = (LAS bf16_t*)lds;
    LAS bf16_t* Vt = (LAS bf16_t*)(lds + 34816);
    LAS float* St = (LAS float*)(lds + 69632);
    const bf16_t* ZZ = (const bf16_t*)(ws + WS_BIG); const float* stats = (const float*)(ws + WS_STATS); bf16_t* YIN = (bf16_t*)(ws + WS_YIN);
    const float* ln_g = pp->in[12]; const float* ln_b = pp->in[13]; const float* w_s = pp->in[14]; const float* b_s = pp->in[15];
    float* st_sgu = pp->out + O_SGU;
    int tid = threadIdx.x; asm volatile("" : "+v"(tid));
    const int wid = tid >> 6, lane = tid & 63, wr = wid >> 2, wc = wid & 3, fr = lane & 15, fq = lane >> 4;
    for (int unit = blockIdx.x; unit < (M / 128) * 16; unit += G) {
        const int rt = unit >> 4, g = unit & 15, r0 = rt * 128, c0 = g * 128; const bool sample = rt >= (MP / 128);
        const int ch = lane & 15, cch = c0 + 8 * ch;
        const f32x4 lg0 = *(const f32x4*)(ln_g + cch), lg1 = *(const f32x4*)(ln_g + cch + 4), lb0 = *(const f32x4*)(ln_b + cch), lb1 = *(const f32x4*)(ln_b + cch + 4);
        u32x4 raw[4], uraw[4];
#pragma unroll
        for (int it = 0; it < 4; ++it) raw[it] = *(const u32x4*)(ZZ + (size_t)(r0 + wid * 16 + it * 4 + (lane >> 4)) * 4096 + 2048 + cch);
#pragma unroll
        for (int m = 0; m < 4; ++m) uraw[m] = *(const u32x4*)(ZZ + (size_t)(r0 + 64 * wr + 16 * m + fr) * 4096 + c0 + 32 * wc + 8 * fq);
        __syncthreads();
        if (tid < 128) { const f32x4* sp = (const f32x4*)(stats + (size_t)(r0 + tid) * 64); float s = 0.f, ss = 0.f;
#pragma unroll
            for (int q = 0; q < 16; ++q) { const f32x4 v = sp[q]; s += v[0] + v[2]; ss += v[1] + v[3]; }
            const float mean = s * (1.0f / 2048.0f), var = ss * (1.0f / 2048.0f) - mean * mean;
            St[2 * tid] = mean; St[2 * tid + 1] = 1.0f / sqrtf(fmaxf(var, 0.f) + EPS); }
        const float* wg = w_s + (size_t)g * 128 * 128;
#pragma unroll
        for (int q = 0; q < 8; ++q) { const int idx = q * NTHREADS + tid, i = idx >> 5, j4 = (idx & 31) * 4;
            int lim, so;
            if (!sample) { so = i * 128 + j4; lim = i - j4; }
            else { const int ii = i & 15, jj = j4 & 15; so = ii * 128 + jj; lim = ((i >> 4) == (j4 >> 4)) ? ii - jj : -1; }
            f32x4 w = *(const f32x4*)(wg + so);
#pragma unroll
            for (int e = 0; e < 4; ++e) w[e] = __uint_as_float(__float_as_uint(w[e]) & ~(unsigned)((lim - e) >> 31));
            u32x2 o; o.x = cvt_pk_bf16(w[0], w[1]); o.y = cvt_pk_bf16(w[2], w[3]);
            *(LAS u32x2*)(Aw + i * 136 + j4) = o; }
        __syncthreads();
        { const int c = cch;
#pragma unroll
            for (int it = 0; it < 4; ++it) { const int j = wid * 16 + it * 4 + (lane >> 4), r = r0 + j; const float mean = St[2 * j], rstd = St[2 * j + 1]; float v[8];
                unpack8(raw[it], v);
#pragma unroll
                for (int e = 0; e < 8; ++e) v[e] = (v[e] - mean) * rstd * (e < 4 ? lg0[e & 3] : lg1[e & 3]) + (e < 4 ? lb0[e & 3] : lb1[e & 3]);
                if (sample) { float* sp = st_sgu + (size_t)(r - MP) * 2048 + c; *(f32x4*)sp = (f32x4){v[0], v[1], v[2], v[3]}; *(f32x4*)(sp + 4) = (f32x4){v[4], v[5], v[6], v[7]}; }
                const int jo = (((j >> 3) ^ ch) << 3) + (j & 7);
#pragma unroll
                for (int e = 0; e < 8; e += 2) { const unsigned pk = cvt_pk_bf16(v[e], v[e + 1]); Vt[(8 * ch + e) * 136 + jo] = (bf16_t)(pk & 0xffffu); Vt[(8 * ch + e + 1) * 136 + jo] = (bf16_t)(pk >> 16); } }
        }
        __syncthreads();
        f32x4 acc[4][2];
#pragma unroll
        for (int m = 0; m < 4; ++m)
#pragma unroll
            for (int n = 0; n < 2; ++n) acc[m][n] = (f32x4){0.f, 0.f, 0.f, 0.f};
#pragma unroll
        for (int k = 0; k < 4; ++k) { bf16x8 Af[4], Bf[2];
#pragma unroll
            for (int m = 0; m < 4; ++m) Af[m] = *(const LAS bf16x8*)(Aw + (64 * wr + 16 * m + fr) * 136 + 32 * k + 8 * fq);
#pragma unroll
            for (int n = 0; n < 2; ++n) { const int d = 32 * wc + 8 * (fr >> 2) + 4 * n + (fr & 3); Bf[n] = *(const LAS bf16x8*)(Vt + d * 136 + (((4 * k + fq) ^ ((d >> 3) & 15)) << 3)); }
#pragma unroll
            for (int m = 0; m < 4; ++m)
#pragma unroll
                for (int n = 0; n < 2; ++n) acc[m][n] = __builtin_amdgcn_mfma_f32_16x16x32_bf16(Bf[n], Af[m], acc[m][n], 0, 0, 0); }
#pragma unroll
        for (int m = 0; m < 4; ++m) { const int i = 64 * wr + 16 * m + fr, r = r0 + i; const float bias = b_s[g * 128 + (sample ? (i & 15) : i)];
            const int d = c0 + 32 * wc + 8 * fq; float u[8]; unpack8(uraw[m], u);
            const f32x4 o0 = (f32x4){u[0], u[1], u[2], u[3]} * (acc[m][0] + bias), o1 = (f32x4){u[4], u[5], u[6], u[7]} * (acc[m][1] + bias);
            *(u32x4*)(YIN + (size_t)r * D + d) = pack8(o0, o1); }
    }
    __syncthreads();
}

#define XB_TMO      128
#define XB_XCNT(j)  (256  + 64 * (j))
#define XB_XSUB(j)  (1280 + 64 * (j))
#define XB_XGEN(j)  (2304 + 64 * (j))
#define XB_TOP      3328
#define XB_TOPGEN   3392
#define XCD_BAR_WORDS 3456
#define XB_SPIN_CAP (1u << 18)
__device__ __forceinline__ unsigned xb_ld(unsigned* p)              { return __hip_atomic_load(p, __ATOMIC_RELAXED, __HIP_MEMORY_SCOPE_AGENT); }
__device__ __forceinline__ unsigned xb_add(unsigned* p, unsigned v) { return __hip_atomic_fetch_add(p, v, __ATOMIC_RELAXED, __HIP_MEMORY_SCOPE_AGENT); }
__device__ __forceinline__ unsigned xb_xcc_id() { return (unsigned)__builtin_amdgcn_s_getreg((3 << 11) | 20) & 0xFu; }
#define XB_SPIN(cond, bar) do { unsigned _sp = 0; while (cond) { __builtin_amdgcn_s_sleep(1); \
    if ((++_sp & 255u) == 0u) { if (xb_ld(&(bar)[XB_TMO])) break; if (_sp > XB_SPIN_CAP) { atomicAdd(&(bar)[XB_TMO], 1u); break; } } } } while (0)
__device__ __forceinline__ void xcd_barrier_complete(unsigned* bar, unsigned x, unsigned& nloc, unsigned& nx) {
    const unsigned G = gridDim.x * gridDim.y * gridDim.z;
    unsigned sum, cnt, mine, sp = 0u;
    for (;;) {
        sum = 0u; cnt = 0u; mine = 0u;
#pragma unroll
        for (unsigned j = 0; j < 16; ++j) { const unsigned c = xb_ld(&bar[XB_XCNT(j)]); sum += c; cnt += (c > 0u) ? 1u : 0u; mine = (j == x) ? c : mine; }
        if (sum == G) break;
        __builtin_amdgcn_s_sleep(1);
        if ((++sp & 255u) == 0u) { if (xb_ld(&bar[XB_TMO])) break; if (sp > XB_SPIN_CAP) { atomicAdd(&bar[XB_TMO], 1u); break; } }
    }
    nloc = mine > 0u ? mine : 1u; nx = cnt > 0u ? cnt : 1u;
}
__device__ __forceinline__ void xcd_barrier(unsigned* bar, volatile LAS unsigned* st) {
    asm volatile("s_waitcnt vmcnt(0)" ::: "memory");
    __syncthreads();
    if (threadIdx.x == 0) {
        __builtin_amdgcn_s_waitcnt(0);
        const unsigned x = xb_xcc_id();
        unsigned nloc = st[0], nx = st[1];
        if (nloc == 0u) { xcd_barrier_complete(bar, x, nloc, nx); st[0] = nloc; st[1] = nx; }
        const unsigned old = xb_add(&bar[XB_XSUB(x)], 1u);
        const unsigned gen = old / nloc;
        if (old + 1u == (gen + 1u) * nloc) {
            __builtin_amdgcn_fence(__ATOMIC_RELEASE, "agent");
            asm volatile("s_waitcnt vmcnt(0)" ::: "memory");
            const unsigned og = xb_add(&bar[XB_TOP], 1u);
            const unsigned tg = og / nx;
            if (og + 1u == (tg + 1u) * nx) xb_add(&bar[XB_TOPGEN], 1u);
            else XB_SPIN(xb_ld(&bar[XB_TOPGEN]) == tg, bar);
            __builtin_amdgcn_fence(__ATOMIC_ACQUIRE, "agent");
            xb_add(&bar[XB_XGEN(x)], 1u);
            asm volatile("s_waitcnt vmcnt(0)" ::: "memory");
        } else {
            XB_SPIN(xb_ld(&bar[XB_XGEN(x)]) == gen, bar);
            __builtin_amdgcn_fence(__ATOMIC_ACQUIRE, "agent");
            asm volatile("s_waitcnt vmcnt(0)" ::: "memory");
        }
    }
    __syncthreads();
}

__global__ void __launch_bounds__(NTHREADS, 2) mega(Params p_arg) {
    extern __shared__ __attribute__((aligned(16))) unsigned char lds_raw[];
    LAS unsigned char* lds = (LAS unsigned char*)lds_raw;
    cg::grid_group grid = cg::this_grid();
    PP pp = (PP)__builtin_amdgcn_kernarg_segment_ptr();
    const int G = gridDim.x, NGW = G * NWAVES;
#define LANE_IDS() int tid = threadIdx.x; asm volatile("" : "+v"(tid)); const int wave = __builtin_amdgcn_readfirstlane(tid >> 6), lane = tid & 63, gw = blockIdx.x * NWAVES + wave

    if (threadIdx.x < 2) ((volatile LAS unsigned*)(lds + LDS_STAGE))[threadIdx.x] = 0u;
    if (threadIdx.x == 0) (void)xb_add(&((unsigned*)(pp->ws + WS_BAR))[XB_XCNT(xb_xcc_id())], 1u);
    if (G > 0x40000000) grid.sync();
    for (int rep = 0; rep < REP_P0; ++rep) { LANE_IDS(); phase0(pp, lds, gw, NGW, wave, lane); }
    GSYNC();

#pragma nounroll
    for (int layer = 0; layer < 2; ++layer) {
        FRESH(pp);
        if (layer == 0) {
            { unsigned char* ws = pp->ws; float* out = pp->out; bf16_t* BIG = (bf16_t*)(ws + WS_BIG);
              pg8::Gemm g{(const bf16_t*)(ws + WS_H), (const bf16_t*)(ws + WS_WAIN), M, 3 * D, D, D, 3 * D / 256}; pg8::StaticOrder S; S.init(M, 3 * D, G, (int)blockIdx.x);
              EpiCZ E{BIG, BIG + (size_t)M * D, out + O_SCP, out + O_SCS};
              for (int rep = 0; rep < REP_GEMM; ++rep) pg8::gemm_phase<EpiCZ>(lds, g, S, E);
              tail_convert(pp, lds, S.nwg, G, CV_P0, CV_T1); }
            GSYNC();
            FRESH(pp);
            for (int rep = 0; rep < REP_MIX; ++rep) conv_phase(pp, G);
            GSYNC();
        } else {
            { unsigned char* ws = pp->ws;
              pg8::Gemm g{(const bf16_t*)(ws + WS_H), (const bf16_t*)(ws + WS_WBIN), M, 2 * D, D, D, 2 * D / 256}; pg8::StaticOrder S; S.init(M, 2 * D, G, (int)blockIdx.x);
              EpiGelu E{(bf16_t*)(ws + WS_BIG), pp->in[11], (float*)(ws + WS_STATS)};
              for (int rep = 0; rep < REP_GEMM; ++rep) pg8::gemm_phase<EpiGelu>(lds, g, S, E);
              tail_convert(pp, lds, S.nwg, G, CV_T3, CV_T8); }
            GSYNC();
            FRESH(pp);
            for (int rep = 0; rep < REP_MIX; ++rep) sgu_phase(pp, lds, G);
            GSYNC();
        }
#pragma nounroll
        for (int sub = 0; sub < 2; ++sub) {
            if (sub == 1) {
                FRESH(pp);
                unsigned char* ws = pp->ws;
                pg8::Gemm g{(const bf16_t*)(ws + WS_H), (const bf16_t*)(ws + (layer ? WS_WGU1 : WS_WGU0)), M, 2 * FF, D, D, 2 * FF / 256}; pg8::StaticOrder S; S.init(M, 2 * FF, G, (int)blockIdx.x);
                EpiGU E{(bf16_t*)(ws + WS_BIG)};
                for (int rep = 0; rep < REP_GEMM; ++rep) pg8::gemm_phase<EpiGU>(lds, g, S, E);
                GSYNC();
            }
            { FRESH(pp);
              unsigned char* ws = pp->ws;
              const bf16_t* A = (const bf16_t*)(ws + (sub ? WS_BIG : WS_YIN)); const int K = sub ? FF : D;
              const bf16_t* Bt = (const bf16_t*)(ws + (sub ? (layer ? WS_WDN1 : WS_WDN0) : (layer ? WS_WBOUT : WS_WAOUT)));
              bf16_t* MB = (bf16_t*)(ws + WS_MB); bf16_t* PT = (bf16_t*)(ws + WS_PART);
              { pg8::Gemm g{A, Bt, MP, D, K, K, D / 256}; pg8::StaticOrder S; S.init(MP, D, G, (int)blockIdx.x);
                EpiPlain E{MB, MB, MB, MB, D, D / 256};
                pg8::gemm_phase<EpiPlain>(lds, g, S, E); }
              const int ks = 4;
              { pg8::Gemm g{A + (size_t)MP * K, Bt, MS, D * ks, K / ks, K, D / 256}; pg8::StaticOrder S; S.init(MS, D * ks, G, (int)blockIdx.x);
                bf16_t* MBS = MB + (size_t)MP * D;
                EpiPlain E{ks == 1 ? MBS : PT, PT + (size_t)MS * D, PT + (size_t)2 * MS * D, PT + (size_t)3 * MS * D, D, D / 256};
                pg8::gemm_phase<EpiPlain>(lds, g, S, E);
                { const int lo = layer == 0 ? (sub ? CV_T1 + I_DN : CV_T1) : CV_T8, hi = layer == 0 ? (sub ? CV_T3 : CV_T1 + I_DN) : (sub ? CV_T8 : CV_T10);
                  tail_convert(pp, lds, G + S.nwg, G, lo, hi); } } }
            GSYNC();
            { FRESH(pp); LANE_IDS();
              unsigned char* ws = pp->ws;
              const bool first = (layer == 0 && sub == 0), lastp = (layer == 1 && sub == 1);
              const float* xp = first ? pp->in[0] : nullptr; const float* xs = first ? pp->in[1] : nullptr;
              const float* gpost = (sub ? pp->in[6] : pp->in[4]) + layer * D;
              const float* gnext = lastp ? nullptr : (sub ? pp->in[3] + D : pp->in[5] + layer * D);
              resnorm_phase(xp, xs, (bf16_t*)(ws + WS_XB), pp->out + O_Y, (const bf16_t*)(ws + WS_MB), (const bf16_t*)(ws + WS_PART), gpost, gnext, (bf16_t*)(ws + WS_H), gw, NGW, lane, lds); }
            if (!(layer == 1 && sub == 1)) GSYNC();
        }
    }
}

extern "C" void kernel_launch(void* const* d_in, const int* in_sizes, int n_in, void* d_out, int out_size, void* d_ws, size_t ws_size, hipStream_t stream) {
    static int grid = 0;
    if (grid == 0) {
        if (ws_size < WS_END) { fprintf(stderr, "kernel_launch: workspace too small: %zu < %zu\n", ws_size, (size_t)WS_END); grid = -1; return; }
        int dev = 0, cus = 0, per_cu = 0;
        (void)hipGetDevice(&dev);
        (void)hipDeviceGetAttribute(&cus, hipDeviceAttributeMultiprocessorCount, dev);
        if (hipFuncSetAttribute((const void*)mega, hipFuncAttributeMaxDynamicSharedMemorySize, LDS_BYTES) != hipSuccess) fprintf(stderr, "kernel_launch: hipFuncSetAttribute failed\n");
        if (hipOccupancyMaxActiveBlocksPerMultiprocessor(&per_cu, (const void*)mega, NTHREADS, LDS_BYTES) != hipSuccess || per_cu < 1) per_cu = 1;
        (void)hipGetLastError();
        grid = cus * per_cu;
    }
    if (grid < 0) return;
    if (hipMemsetAsync((char*)d_ws + WS_BAR, 0, XCD_BAR_WORDS * 4, stream) != hipSuccess) fprintf(stderr, "kernel_launch: memset of the barrier words failed\n");
    Params p{};
    for (int i = 0; i < 20; ++i) p.in[i] = (const float*)d_in[i];
    p.out = (float*)d_out; p.ws = (unsigned char*)d_ws;
    void* args[] = {&p};
    hipError_t e = hipLaunchCooperativeKernel((const void*)mega, dim3(grid), dim3(NTHREADS), args, LDS_BYTES, stream);
    if (e != hipSuccess) fprintf(stderr, "cooperative launch failed: %s (grid %d)\n", hipGetErrorString(e), grid);
}
```

```cpp
#include <hip/hip_runtime.h>
#include <hip/hip_cooperative_groups.h>
#include <cstdio>
namespace cg = cooperative_groups;

#define LAS __attribute__((address_space(3)))
typedef unsigned short bf16_t;
typedef short bf16x8 __attribute__((ext_vector_type(8)));
typedef float f32x4 __attribute__((ext_vector_type(4)));
typedef float f32x2 __attribute__((ext_vector_type(2)));
typedef unsigned u32x4 __attribute__((ext_vector_type(4)));
typedef unsigned u32x2 __attribute__((ext_vector_type(2)));

#define REP_P0 1
#define REP_SYNC 1
#define REP_GEMM 1
#define REP_MIX 1
#define REP_RES 1
#define GSYNC() do { for (int _r = 0; _r < REP_SYNC; ++_r) xcd_barrier((unsigned*)(pp->ws + WS_BAR), (volatile LAS unsigned*)(lds + LDS_STAGE)); } while (0)

constexpr int D = 2048, MP = 8192, MS = 512, M = MP + MS, FF = 5632;
constexpr float EPS = 1e-6f;
constexpr int NTHREADS = 512, NWAVES = 8;
constexpr int LDS_STAGE = 131072;
constexpr int LDS_BYTES = LDS_STAGE + 16;

constexpr size_t WS_WAIN = 0;
constexpr size_t WS_WAOUT = WS_WAIN + (size_t)6144 * 2048 * 2;
constexpr size_t WS_WBIN = WS_WAOUT + (size_t)2048 * 2048 * 2;
constexpr size_t WS_WBOUT = WS_WBIN + (size_t)4096 * 2048 * 2;
constexpr size_t WS_WGU0 = WS_WBOUT + (size_t)2048 * 2048 * 2;
constexpr size_t WS_WGU1 = WS_WGU0 + (size_t)11264 * 2048 * 2;
constexpr size_t WS_WDN0 = WS_WGU1 + (size_t)11264 * 2048 * 2;
constexpr size_t WS_WDN1 = WS_WDN0 + (size_t)2048 * 5632 * 2;
constexpr size_t WS_H = WS_WDN1 + (size_t)2048 * 5632 * 2;
constexpr size_t WS_BIG = WS_H + (size_t)M * 2048 * 2;
constexpr size_t WS_YIN = WS_BIG + (size_t)M * 5632 * 2;
constexpr size_t WS_MB = WS_YIN + (size_t)M * 2048 * 2;
constexpr size_t WS_STATS = WS_MB + (size_t)M * 2048 * 2;
constexpr size_t WS_XB = WS_STATS + (size_t)M * 64 * 4;
constexpr size_t WS_PART = WS_XB + (size_t)M * 2048 * 2;
constexpr size_t WS_BAR = WS_PART + (size_t)4 * MS * 2048 * 2;
constexpr size_t WS_END = WS_BAR + 3456 * 4;

constexpr size_t O_Y = 0;
constexpr size_t O_SCP = (size_t)M * D;
constexpr size_t O_SCS = O_SCP + 4 * 2 * 2048;
constexpr size_t O_SGU = O_SCS + 32 * 2 * 2048;

struct Params { const float* in[20]; float* out; unsigned char* ws; };
typedef const __attribute__((address_space(4))) Params* PP;
#define FRESH(pp) asm volatile("" : "+s"(pp) :: "memory")

__device__ __forceinline__ unsigned cvt_pk_bf16(float lo, float hi) { unsigned r; asm("v_cvt_pk_bf16_f32 %0, %1, %2" : "=v"(r) : "v"(lo), "v"(hi)); return r; }
__device__ __forceinline__ float bf_lo(unsigned w) { return __uint_as_float(w << 16); }
__device__ __forceinline__ float bf_hi(unsigned w) { return __uint_as_float(w & 0xffff0000u); }
__device__ __forceinline__ float wave_sum(float v) {
#pragma unroll
    for (int o = 1; o < 64; o <<= 1) v += __shfl_xor(v, o);
    return v;
}
__device__ __forceinline__ f32x2 gelu_pk(f32x2 v) {
    const f32x2 av = __builtin_elementwise_abs(v), d = av * 0.2316418882f + 1.0f;
    f32x2 t; t.x = __builtin_amdgcn_rcpf(d.x); t.y = __builtin_amdgcn_rcpf(d.y);
    f32x2 q = t * 0.5307027145f + (-0.7265760135f); q = q * t + 0.7107068705f; q = q * t + (-0.142248368f); q = q * t + 0.127414796f; q = q * t;
    const f32x2 s = (v * v) * (-0.72134752044f);
    f32x2 e; e.x = __builtin_amdgcn_exp2f(s.x); e.y = __builtin_amdgcn_exp2f(s.y);
    const f32x2 h = 0.5f - q * e;
    return v * 0.5f + av * h;
}
__device__ __forceinline__ f32x4 gelu4(f32x4 v) { f32x2 a = gelu_pk((f32x2){v[0], v[1]}), b = gelu_pk((f32x2){v[2], v[3]}); return (f32x4){a.x, a.y, b.x, b.y}; }
__device__ __forceinline__ float silu1(float x) { return x * __builtin_amdgcn_rcpf(1.0f + __builtin_amdgcn_exp2f(-1.4426950408889634f * x)); }
__device__ __forceinline__ f32x4 silu_mul4(f32x4 g, f32x4 u) {
    const f32x4 t = g * (-1.4426950408889634f);
    f32x4 e; e[0] = __builtin_amdgcn_exp2f(t[0]); e[1] = __builtin_amdgcn_exp2f(t[1]); e[2] = __builtin_amdgcn_exp2f(t[2]); e[3] = __builtin_amdgcn_exp2f(t[3]);
    const f32x4 d = e + 1.0f, gu = g * u;
    f32x4 r; r[0] = __builtin_amdgcn_rcpf(d[0]); r[1] = __builtin_amdgcn_rcpf(d[1]); r[2] = __builtin_amdgcn_rcpf(d[2]); r[3] = __builtin_amdgcn_rcpf(d[3]);
    return gu * r;
}

namespace pg8 {
constexpr int BM = 256, BK = 64, HALF = 128, HTB = HALF * BK * 2, NXCD = 8, WGM = 8;
__device__ __forceinline__ int lds_byte(int r, int c) { const int st = (r >> 4) * 2 + (c >> 5), rr = r & 15, cc = c & 31, ob = rr * 64 + cc * 2; return st * 1024 + (ob ^ (((ob >> 9) & 1) << 5)); }
__device__ __forceinline__ void stage_rc(int b, int& R, int& C) { const int st = b / 1024, sb = b % 1024, swz = sb ^ (((sb >> 9) & 1) << 5); R = (st >> 1) * 16 + swz / 64; C = (st & 1) * 32 + (swz % 64) / 2; }
__device__ __forceinline__ int perm32(int rho) { const int n = rho >> 4, i = rho & 15; return 8 * (i >> 2) + 4 * n + (i & 3); }

struct Unit { int pm, pn; };
struct Gemm { const bf16_t* A; const bf16_t* Bt; int M, N, K, ldk, nn; };
struct StaticOrder {
    int nM, nN, nwg, G, c;
    __device__ void init(int M_, int N_, int G_, int c_) { nM = M_ / BM; nN = N_ / BM; nwg = nM * nN; G = G_; c = c_; }
    __device__ bool next(int i, Unit& u) const {
        const long L = (long)i * G + c; if (L >= nwg) return false;
        int wgid = (int)L; { const int q = nwg / NXCD, r = nwg % NXCD, xcd = wgid % NXCD, off = wgid / NXCD; wgid = (xcd < r ? xcd * (q + 1) : r * (q + 1) + (xcd - r) * q) + off; }
        const int nig = WGM * nN, gid = wgid / nig, fm = gid * WGM, gsz = (nM - fm) < WGM ? (nM - fm) : WGM;
        u.pm = fm + ((wgid % nig) % gsz); u.pn = (wgid % nig) / gsz; return true;
    }
};

template <class Epi>
__device__ __forceinline__ void gemm_phase(LAS unsigned char* lds, const Gemm g, const StaticOrder& S, const Epi& E) {
    int tid = threadIdx.x; asm volatile("" : "+v"(tid));
    const int wid = __builtin_amdgcn_readfirstlane(tid >> 6), lane = tid & 63, wr = wid >> 2, wc = wid & 3, fr = lane & 15, fq = lane >> 4;
    const int K = g.K, nt = K / BK;
    unsigned voffA[2], voffB[2];
#pragma unroll
    for (int i = 0; i < 2; ++i) { int R, C; stage_rc(tid * 16 + i * 8192, R, C); const int Rb = (R & ~31) + perm32(R & 31);
        voffA[i] = (unsigned)(R * g.ldk + C) * 2u; voffB[i] = (unsigned)(Rb * g.ldk + C) * 2u; }
    const size_t kstep = (size_t)(BK * 2);
    const size_t hstep = (size_t)HALF * g.ldk * 2;
    const size_t tstep = 2 * hstep;
    const unsigned ldsw = (unsigned)wid * 1024u;
    const int aoff = lds_byte(wr * 64 + fr, fq * 8), boff = lds_byte(wc * 32 + fr, fq * 8);
#define PG8_SA(b, h) (((b) * 2 + (h)) * HTB)
#define PG8_SB(b, h) ((4 + (b) * 2 + (h)) * HTB)
#define PG8_STAGE(bufoff, gbase, voff) do { _Pragma("unroll") for (int _i = 0; _i < 2; ++_i) \
        __builtin_amdgcn_global_load_lds((const unsigned*)((const char*)(gbase) + (voff)[_i]), (LAS unsigned*)(lds + (bufoff) + ldsw + _i * 8192), 16, 0, 0); } while (0)
#define PG8_LDA(dst, b, h) do { _Pragma("unroll") for (int m = 0; m < 4; ++m) _Pragma("unroll") for (int k = 0; k < 2; ++k) dst[m][k] = *(const LAS bf16x8*)(lds + PG8_SA(b, h) + aoff + m * 2048 + k * 1024); } while (0)
#define PG8_LDB(dst, b, h) do { _Pragma("unroll") for (int n = 0; n < 2; ++n) _Pragma("unroll") for (int k = 0; k < 2; ++k) dst[n][k] = *(const LAS bf16x8*)(lds + PG8_SB(b, h) + boff + n * 2048 + k * 1024); } while (0)
#define PG8_MMA(ai, bj, At, Bt) do { __builtin_amdgcn_s_setprio(1); _Pragma("unroll") for (int m = 0; m < 4; ++m) _Pragma("unroll") for (int n = 0; n < 2; ++n) _Pragma("unroll") for (int k = 0; k < 2; ++k) \
        acc[ai][bj][m][n] = __builtin_amdgcn_mfma_f32_16x16x32_bf16(Bt[n][k], At[m][k], acc[ai][bj][m][n], 0, 0, 0); __builtin_amdgcn_s_setprio(0); } while (0)
#define PG8_WAIT_V(n) asm volatile("s_waitcnt vmcnt(" #n ")" ::: "memory")
#define PG8_WAIT_L(n) asm volatile("s_waitcnt lgkmcnt(" #n ")" ::: "memory")
#define PG8_BAR __builtin_amdgcn_s_barrier()
#define PG8_SCHED __builtin_amdgcn_sched_barrier(0)
    Unit cur, nxt; int ui = 0;
    if (!S.next(0, cur)) return;
    f32x4 acc[2][2][4][2];
#pragma unroll
    for (int a = 0; a < 2; ++a)
#pragma unroll
        for (int b = 0; b < 2; ++b)
#pragma unroll
            for (int m = 0; m < 4; ++m)
#pragma unroll
                for (int n = 0; n < 2; ++n) acc[a][b][m][n] = (f32x4){0.f, 0.f, 0.f, 0.f};
    bf16x8 At[4][2], B0[2][2], B1[2][2];
    const size_t pstep = (size_t)K * 2;
    const char* cA = (const char*)g.A + (size_t)cur.pm * tstep + (size_t)(cur.pn / g.nn) * pstep; const char* cB = (const char*)g.Bt + (size_t)(cur.pn % g.nn) * tstep + (size_t)(cur.pn / g.nn) * pstep;
    PG8_STAGE(PG8_SB(0, 0), cB, voffB); PG8_STAGE(PG8_SA(0, 0), cA, voffA); PG8_STAGE(PG8_SB(0, 1), cB + hstep, voffB); PG8_STAGE(PG8_SA(0, 1), cA + hstep, voffA);
    if (wr == 1) PG8_BAR;
    PG8_WAIT_V(4); PG8_BAR;
    PG8_STAGE(PG8_SB(1, 0), cB + kstep, voffB); PG8_STAGE(PG8_SA(1, 0), cA + kstep, voffA); PG8_STAGE(PG8_SB(1, 1), cB + hstep + kstep, voffB);
    PG8_WAIT_V(6); PG8_BAR;
    for (;;) {
        const bool has_next = S.next(ui + 1, nxt);
        const char* nA = has_next ? (const char*)g.A + (size_t)nxt.pm * tstep + (size_t)(nxt.pn / g.nn) * pstep : cA; const char* nB = has_next ? (const char*)g.Bt + (size_t)(nxt.pn % g.nn) * tstep + (size_t)(nxt.pn / g.nn) * pstep : cB;
        asm volatile(".p2align 8");
        for (int t = 0; t < nt; t += 2) {
            const bool last = (t == nt - 2);
            const char* a1 = cA + (size_t)(t + 1) * kstep;
            const char* a2 = last ? nA : cA + (size_t)(t + 2) * kstep; const char* b2 = last ? nB : cB + (size_t)(t + 2) * kstep;
            const char* a3 = a2 + kstep; const char* b3 = b2 + kstep;
            PG8_LDB(B0, 0, 0); PG8_SCHED; PG8_LDA(At, 0, 0); PG8_STAGE(PG8_SA(1, 1), a1 + hstep, voffA);
            PG8_WAIT_L(8); PG8_BAR; PG8_WAIT_L(0); PG8_MMA(0, 0, At, B0); PG8_BAR; PG8_SCHED;
            PG8_LDB(B1, 0, 1); PG8_STAGE(PG8_SB(0, 0), b2, voffB);
            PG8_BAR; PG8_WAIT_L(0); PG8_MMA(0, 1, At, B1); PG8_BAR;
            PG8_LDA(At, 0, 1); PG8_STAGE(PG8_SA(0, 0), a2, voffA);
            PG8_BAR; PG8_WAIT_L(0); PG8_MMA(1, 0, At, B0); PG8_BAR; PG8_SCHED;
            PG8_STAGE(PG8_SB(0, 1), b2 + hstep, voffB);
            PG8_WAIT_V(6); PG8_BAR; PG8_MMA(1, 1, At, B1); PG8_BAR;
            PG8_LDB(B0, 1, 0); PG8_SCHED; PG8_LDA(At, 1, 0); PG8_STAGE(PG8_SA(0, 1), a2 + hstep, voffA);
            PG8_WAIT_L(8); PG8_BAR; PG8_WAIT_L(0); PG8_MMA(0, 0, At, B0); PG8_BAR; PG8_SCHED;
            PG8_LDB(B1, 1, 1); PG8_STAGE(PG8_SB(1, 0), b3, voffB);
            PG8_BAR; PG8_WAIT_L(0); PG8_MMA(0, 1, At, B1); PG8_BAR;
            PG8_LDA(At, 1, 1); PG8_STAGE(PG8_SA(1, 0), a3, voffA);
            PG8_BAR; PG8_WAIT_L(0); PG8_MMA(1, 0, At, B0); PG8_BAR; PG8_SCHED;
            PG8_STAGE(PG8_SB(1, 1), b3 + hstep, voffB);
            PG8_WAIT_V(6); PG8_BAR; PG8_MMA(1, 1, At, B1); PG8_BAR;
        }
        E(acc, cur, wr, wc, fr, fq);
        if (!has_next) break;
#pragma unroll
        for (int a = 0; a < 2; ++a)
#pragma unroll
            for (int b = 0; b < 2; ++b)
#pragma unroll
                for (int m = 0; m < 4; ++m)
#pragma unroll
                    for (int n = 0; n < 2; ++n) acc[a][b][m][n] = (f32x4){0.f, 0.f, 0.f, 0.f};
        cur = nxt; cA = nA; cB = nB; ++ui;
    }
    PG8_WAIT_V(0);
    if (wr == 0) PG8_BAR;
    PG8_BAR;
#undef PG8_SA
#undef PG8_SB
#undef PG8_STAGE
#undef PG8_LDA
#undef PG8_LDB
#undef PG8_MMA
#undef PG8_WAIT_V
#undef PG8_WAIT_L
#undef PG8_BAR
#undef PG8_SCHED
}
}
using pg8::Unit;

__device__ __forceinline__ u32x4 pack8(f32x4 v0, f32x4 v1) { u32x4 w; w.x = cvt_pk_bf16(v0[0], v0[1]); w.y = cvt_pk_bf16(v0[2], v0[3]); w.z = cvt_pk_bf16(v1[0], v1[1]); w.w = cvt_pk_bf16(v1[2], v1[3]); return w; }

struct EpiPlain {
    bf16_t* O0; bf16_t* O1; bf16_t* O2; bf16_t* O3; int ldc, nn;
    __device__ __forceinline__ void operator()(const f32x4 (&acc)[2][2][4][2], const Unit& u, int wr, int wc, int fr, int fq) const {
        const int kh = u.pn / nn, pn = u.pn - kh * nn; bf16_t* O = kh == 0 ? O0 : (kh == 1 ? O1 : (kh == 2 ? O2 : O3));
        const int row0 = u.pm * 256 + wr * 64 + fr, col0 = pn * 256 + wc * 32 + 8 * fq;
#pragma unroll
        for (int ai = 0; ai < 2; ++ai)
#pragma unroll
            for (int m = 0; m < 4; ++m) { bf16_t* rowp = O + (size_t)(row0 + ai * 128 + m * 16) * ldc + col0;
#pragma unroll
                for (int bj = 0; bj < 2; ++bj) *(u32x4*)(rowp + bj * 128) = pack8(acc[ai][bj][m][0], acc[ai][bj][m][1]); }
    }
};
struct EpiGU {
    bf16_t* O;
    __device__ __forceinline__ void operator()(const f32x4 (&acc)[2][2][4][2], const Unit& u, int wr, int wc, int fr, int fq) const {
        const int row0 = u.pm * 256 + wr * 64 + fr, col0 = u.pn * 128 + wc * 32 + 8 * fq;
#pragma unroll
        for (int ai = 0; ai < 2; ++ai)
#pragma unroll
            for (int m = 0; m < 4; ++m) { bf16_t* rowp = O + (size_t)(row0 + ai * 128 + m * 16) * FF + col0;
                const f32x4 o0 = silu_mul4(acc[ai][0][m][0], acc[ai][1][m][0]), o1 = silu_mul4(acc[ai][0][m][1], acc[ai][1][m][1]);
                *(u32x4*)rowp = pack8(o0, o1); }
    }
};
struct EpiCZ {
    bf16_t* GB; bf16_t* CZ; float* scp; float* scs;
    __device__ __forceinline__ void operator()(const f32x4 (&acc)[2][2][4][2], const Unit& u, int wr, int wc, int fr, int fq) const {
        const int row0 = u.pm * 256 + wr * 64 + fr;
        if (u.pn < 16) {
            const int col0 = u.pn * 128 + wc * 32 + 8 * fq;
#pragma unroll
            for (int ai = 0; ai < 2; ++ai)
#pragma unroll
                for (int m = 0; m < 4; ++m) { const int r = row0 + ai * 128 + m * 16;
                    const f32x4 c0 = acc[ai][0][m][0] * acc[ai][1][m][0], c1 = acc[ai][0][m][1] * acc[ai][1][m][1];
                    *(u32x4*)(CZ + (size_t)r * D + col0) = pack8(c0, c1);
                    float* sp = nullptr;
                    if (r < MP) { const int t = r & 2047; if (t >= 2046) sp = scp + (size_t)((r >> 11) * 2 + (t - 2046)) * D; }
                    else { const int t = r & 15; if (t >= 14) sp = scs + (size_t)(((r - MP) >> 4) * 2 + (t - 14)) * D; }
                    if (sp) { *(f32x4*)(sp + col0) = c0; *(f32x4*)(sp + col0 + 4) = c1; } }
        } else {
            const int col0 = (u.pn - 16) * 256 + wc * 32 + 8 * fq;
#pragma unroll
            for (int ai = 0; ai < 2; ++ai)
#pragma unroll
                for (int m = 0; m < 4; ++m) { bf16_t* rowp = GB + (size_t)(row0 + ai * 128 + m * 16) * D + col0;
#pragma unroll
                    for (int bj = 0; bj < 2; ++bj) *(u32x4*)(rowp + bj * 128) = pack8(acc[ai][bj][m][0], acc[ai][bj][m][1]); }
        }
    }
};
struct EpiGelu {
    bf16_t* O; const float* bias; float* stats;
    __device__ __forceinline__ void operator()(const f32x4 (&acc)[2][2][4][2], const Unit& u, int wr, int wc, int fr, int fq) const {
        const int row0 = u.pm * 256 + wr * 64 + fr, col0 = u.pn * 256 + wc * 32 + 8 * fq;
        f32x4 bv[2][2];
#pragma unroll
        for (int bj = 0; bj < 2; ++bj)
#pragma unroll
            for (int n = 0; n < 2; ++n) bv[bj][n] = *(const f32x4*)(bias + col0 + bj * 128 + 4 * n);
#pragma unroll
        for (int ai = 0; ai < 2; ++ai)
#pragma unroll
            for (int m = 0; m < 4; ++m) { const int r = row0 + ai * 128 + m * 16; bf16_t* rowp = O + (size_t)r * 4096 + col0; float s = 0.f, ss = 0.f;
#pragma unroll
                for (int bj = 0; bj < 2; ++bj) { const f32x4 v0 = gelu4(acc[ai][bj][m][0] + bv[bj][0]), v1 = gelu4(acc[ai][bj][m][1] + bv[bj][1]);
                    s += (v0[0] + v0[1]) + (v0[2] + v0[3]) + (v1[0] + v1[1]) + (v1[2] + v1[3]);
                    ss += (v0[0] * v0[0] + v0[1] * v0[1]) + (v0[2] * v0[2] + v0[3] * v0[3]) + (v1[0] * v1[0] + v1[1] * v1[1]) + (v1[2] * v1[2] + v1[3] * v1[3]);
                    *(u32x4*)(rowp + bj * 128) = pack8(v0, v1); }
                if (u.pn >= 8) { s += __shfl_xor(s, 16); s += __shfl_xor(s, 32); ss += __shfl_xor(ss, 16); ss += __shfl_xor(ss, 32);
                    if (fq == 0) *(f32x2*)(stats + ((size_t)r * 32 + (u.pn - 8) * 4 + wc) * 2) = (f32x2){s, ss}; } }
    }
};

__device__ __forceinline__ void transpose_item(const float* W, int K, int N, bf16_t* WT, int mode, LAS float* scr, int item, int lane) {
    const int nblk = N / 32, kb = item / nblk, nb = item % nblk, k0 = 64 * kb, n0 = 32 * nb;
    int row0;
    if (mode == 0) row0 = n0;
    else if (mode == 1) row0 = 256 * (n0 >> 7) + (n0 & 127);
    else if (mode == 2) row0 = 256 * (n0 >> 7) + 128 + (n0 & 127);
    else { const int part = n0 >> 11, c = n0 & 2047; row0 = part == 0 ? 4096 + c : (256 * (c >> 7) + (part == 2 ? 128 : 0) + (c & 127)); }
#pragma unroll 8
    for (int i = 0; i < 32; ++i) { const int kk = 2 * i + (lane >> 5); scr[kk * 33 + (lane & 31)] = __builtin_nontemporal_load(W + (size_t)(k0 + kk) * N + n0 + (lane & 31)); }
    asm volatile("s_waitcnt lgkmcnt(0)" ::: "memory");
    const int c = lane & 7;
#pragma unroll
    for (int j = 0; j < 4; ++j) { const int n = (lane >> 3) + 8 * j; const LAS float* s = scr + (8 * c) * 33 + n;
        u32x4 o; o.x = cvt_pk_bf16(s[0 * 33], s[1 * 33]); o.y = cvt_pk_bf16(s[2 * 33], s[3 * 33]); o.z = cvt_pk_bf16(s[4 * 33], s[5 * 33]); o.w = cvt_pk_bf16(s[6 * 33], s[7 * 33]);
        __builtin_nontemporal_store(o, (u32x4*)(WT + (size_t)(row0 + n) * K + k0 + 8 * c)); }
    asm volatile("s_waitcnt lgkmcnt(0)" ::: "memory");
}

constexpr int I_AIN = 32 * 192, I_SQ = 32 * 64, I_BIN = 32 * 128, I_GU = 32 * 176, I_DN = 88 * 64;
constexpr int CV_P0 = I_AIN + I_SQ, CV_T1 = CV_P0 + 2 * I_GU, CV_T3 = CV_T1 + I_DN + I_BIN + I_SQ, CV_T8 = CV_T3 + 2 * I_GU, CV_T10 = CV_T8 + I_DN;
__device__ __forceinline__ void convert_items(PP pp, LAS unsigned char* lds, int lo, int hi, int w, int nw, int wave, int lane) {
    LAS float* scr = (LAS float*)(lds + wave * 8448);
    unsigned char* ws = pp->ws;
    for (int it = lo + w; it < hi; it += nw) {
        int r = it;
        if (r < I_AIN) { transpose_item(pp->in[7], D, 3 * D, (bf16_t*)(ws + WS_WAIN), 3, scr, r, lane); continue; } r -= I_AIN;
        if (r < I_SQ) { transpose_item(pp->in[9], D, D, (bf16_t*)(ws + WS_WAOUT), 0, scr, r, lane); continue; } r -= I_SQ;
        if (r < I_GU) { transpose_item(pp->in[17], D, FF, (bf16_t*)(ws + WS_WGU0), 1, scr, r, lane); continue; } r -= I_GU;
        if (r < I_GU) { transpose_item(pp->in[18], D, FF, (bf16_t*)(ws + WS_WGU0), 2, scr, r, lane); continue; } r -= I_GU;
        if (r < I_DN) { transpose_item(pp->in[19], FF, D, (bf16_t*)(ws + WS_WDN0), 0, scr, r, lane); continue; } r -= I_DN;
        if (r < I_BIN) { transpose_item(pp->in[10], D, 2 * D, (bf16_t*)(ws + WS_WBIN), 0, scr, r, lane); continue; } r -= I_BIN;
        if (r < I_SQ) { transpose_item(pp->in[16], D, D, (bf16_t*)(ws + WS_WBOUT), 0, scr, r, lane); continue; } r -= I_SQ;
        if (r < I_GU) { transpose_item(pp->in[17] + (size_t)D * FF, D, FF, (bf16_t*)(ws + WS_WGU1), 1, scr, r, lane); continue; } r -= I_GU;
        if (r < I_GU) { transpose_item(pp->in[18] + (size_t)D * FF, D, FF, (bf16_t*)(ws + WS_WGU1), 2, scr, r, lane); continue; } r -= I_GU;
        transpose_item(pp->in[19] + (size_t)FF * D, FF, D, (bf16_t*)(ws + WS_WDN1), 0, scr, r, lane);
    }
}
__device__ __forceinline__ void tail_convert(PP pp, LAS unsigned char* lds, int nwg, int G, int lo, int hi) {
    const int rem = nwg % G;
    if ((int)blockIdx.x < rem || lo >= hi) return;
    int tid = threadIdx.x; asm volatile("" : "+v"(tid));
    const int wave = __builtin_amdgcn_readfirstlane(tid >> 6), lane = tid & 63;
    convert_items(pp, lds, lo, hi, ((int)blockIdx.x - rem) * NWAVES + wave, (G - rem) * NWAVES, wave, lane);
}

__device__ __forceinline__ void phase0(PP pp, LAS unsigned char* lds, int gw, int NGW, int wave, int lane) {
    unsigned char* ws = pp->ws;
    convert_items(pp, lds, 0, CV_P0, gw, NGW, wave, lane);
    bf16_t* H = (bf16_t*)(ws + WS_H);
    const float* gpre = pp->in[3];
    for (int row = gw; row < M; row += 2 * NGW) {
        const int rowB = row + NGW; const bool hasB = rowB < M;
        const float* xa = row < MP ? pp->in[0] + (size_t)row * D : pp->in[1] + (size_t)(row - MP) * D;
        const float* xbp = !hasB ? xa : (rowB < MP ? pp->in[0] + (size_t)rowB * D : pp->in[1] + (size_t)(rowB - MP) * D);
        f32x4 va[4][2], vb[4][2]; float sa = 0.f, sb = 0.f;
#pragma unroll
        for (int j = 0; j < 4; ++j)
#pragma unroll
            for (int h = 0; h < 2; ++h) va[j][h] = __builtin_nontemporal_load((const f32x4*)(xa + 512 * j + 8 * lane + 4 * h));
#pragma unroll
        for (int j = 0; j < 4; ++j)
#pragma unroll
            for (int h = 0; h < 2; ++h) vb[j][h] = __builtin_nontemporal_load((const f32x4*)(xbp + 512 * j + 8 * lane + 4 * h));
#pragma unroll
        for (int j = 0; j < 4; ++j)
#pragma unroll
            for (int h = 0; h < 2; ++h) { const f32x4 v = va[j][h]; sa += (v[0] * v[0] + v[1] * v[1]) + (v[2] * v[2] + v[3] * v[3]); const f32x4 w = vb[j][h]; sb += (w[0] * w[0] + w[1] * w[1]) + (w[2] * w[2] + w[3] * w[3]); }
        const float ra = 1.0f / sqrtf(wave_sum(sa) * (1.0f / D) + EPS), rb = 1.0f / sqrtf(wave_sum(sb) * (1.0f / D) + EPS);
#pragma unroll
        for (int j = 0; j < 4; ++j) { const f32x4 g0 = *(const f32x4*)(gpre + 512 * j + 8 * lane), g1 = *(const f32x4*)(gpre + 512 * j + 8 * lane + 4);
            *(u32x4*)(H + (size_t)row * D + 512 * j + 8 * lane) = pack8(va[j][0] * ra * g0, va[j][1] * ra * g1);
            if (hasB) *(u32x4*)(H + (size_t)rowB * D + 512 * j + 8 * lane) = pack8(vb[j][0] * rb * g0, vb[j][1] * rb * g1); }
    }
}

__device__ __forceinline__ void unpack8(u32x4 w, float (&f)[8]) { f[0] = bf_lo(w.x); f[1] = bf_hi(w.x); f[2] = bf_lo(w.y); f[3] = bf_hi(w.y); f[4] = bf_lo(w.z); f[5] = bf_hi(w.z); f[6] = bf_lo(w.w); f[7] = bf_hi(w.w); }
__device__ __forceinline__ void conv_hist(const float* cache, int s0, int hi, int c, float (&p)[8]) {
    if (s0 < MP) {
#pragma unroll
        for (int e = 0; e < 8; ++e) p[e] = 0.f;
    } else { const float* hp = cache + (size_t)(((s0 - MP) >> 4) * 2 + hi) * D + c; const f32x4 a = *(const f32x4*)hp, b = *(const f32x4*)(hp + 4);
        p[0] = a[0]; p[1] = a[1]; p[2] = a[2]; p[3] = a[3]; p[4] = b[0]; p[5] = b[1]; p[6] = b[2]; p[7] = b[3]; }
}
__device__ __forceinline__ void conv_phase(PP pp, int G) {
    unsigned char* ws = pp->ws;
    const bf16_t* GB = (const bf16_t*)(ws + WS_BIG); const bf16_t* CZ = GB + (size_t)M * D; bf16_t* YIN = (bf16_t*)(ws + WS_YIN);
    const float* cw = pp->in[8]; const float* cache = pp->in[2];
    int tid = threadIdx.x; asm volatile("" : "+v"(tid));
    constexpr int R = 17; static_assert(M % R == 0, "row blocks");
    for (int item = blockIdx.x * NTHREADS + tid; item < (M / R) * 256; item += G * NTHREADS) {
        const int cb = item & 255, rb = item >> 8, r0 = rb * R, c = cb * 8;
        float w0[8], w1[8], w2[8], p2[8], p1[8];
#pragma unroll
        for (int e = 0; e < 8; ++e) { w0[e] = cw[c + e]; w1[e] = cw[D + c + e]; w2[e] = cw[2 * D + c + e]; }
        { const int s0 = r0 < MP ? (r0 & ~2047) : MP + ((r0 - MP) & ~15);
          if (r0 - 2 >= s0) unpack8(*(const u32x4*)(CZ + (size_t)(r0 - 2) * D + c), p2); else conv_hist(cache, s0, r0 - s0, c, p2);
          if (r0 - 1 >= s0) unpack8(*(const u32x4*)(CZ + (size_t)(r0 - 1) * D + c), p1); else conv_hist(cache, s0, 1, c, p1); }
#pragma unroll
        for (int ch = 0; ch < 2; ++ch) { constexpr int CH = 9; const int i0 = ch * CH, i1 = ch ? R : CH;
            u32x4 czr[CH], gbr[CH];
#pragma unroll
            for (int i = i0; i < i1; ++i) { const size_t off = (size_t)(r0 + i) * D + c; czr[i - i0] = __builtin_nontemporal_load((const u32x4*)(CZ + off)); gbr[i - i0] = __builtin_nontemporal_load((const u32x4*)(GB + off)); }
#pragma unroll
            for (int i = i0; i < i1; ++i) { const int r = r0 + i; const size_t off = (size_t)r * D + c; float cu[8], gb[8], y[8];
                if (i > 0) { const bool start = r < MP ? ((r & 2047) == 0) : (((r - MP) & 15) == 0); if (start) { conv_hist(cache, r, 0, c, p2); conv_hist(cache, r, 1, c, p1); } }
                unpack8(czr[i - i0], cu); unpack8(gbr[i - i0], gb);
#pragma unroll
                for (int e = 0; e < 8; ++e) { y[e] = gb[e] * (w0[e] * p2[e] + w1[e] * p1[e] + w2[e] * cu[e]); p2[e] = p1[e]; p1[e] = cu[e]; }
                u32x4 o; o.x = cvt_pk_bf16(y[0], y[1]); o.y = cvt_pk_bf16(y[2], y[3]); o.z = cvt_pk_bf16(y[4], y[5]); o.w = cvt_pk_bf16(y[6], y[7]);
                *(u32x4*)(YIN + off) = o; } }
    }
}

struct RnRow { f32x4 xf[4][2]; u32x4 xr[4]; u32x4 mr[4]; };
__device__ __forceinline__ void rn_load(RnRow& R, int row, const float* xp, const bf16_t* xb, const bf16_t* mb, int lane) {
    if (xp) {
#pragma unroll
        for (int j = 0; j < 4; ++j) { R.xf[j][0] = __builtin_nontemporal_load((const f32x4*)(xp + (size_t)row * D + 512 * j + 8 * lane)); R.xf[j][1] = __builtin_nontemporal_load((const f32x4*)(xp + (size_t)row * D + 512 * j + 8 * lane + 4)); }
    } else {
#pragma unroll
        for (int j = 0; j < 4; ++j) R.xr[j] = __builtin_nontemporal_load((const u32x4*)(xb + (size_t)row * D + 512 * j + 8 * lane));
    }
#pragma unroll
    for (int j = 0; j < 4; ++j) R.mr[j] = __builtin_nontemporal_load((const u32x4*)(mb + (size_t)row * D + 512 * j + 8 * lane));
}
__device__ __forceinline__ void rn_finish(RnRow& R, int row, bool from_f32, bf16_t* xb, float* xout, const float* gpost, const float* gnext, bf16_t* H, int lane) {
    float mf[4][8]; f32x4 xv[4][2]; float ss = 0.f;
#pragma unroll
    for (int j = 0; j < 4; ++j) {
        if (from_f32) { xv[j][0] = R.xf[j][0]; xv[j][1] = R.xf[j][1]; }
        else { float t[8]; unpack8(R.xr[j], t); xv[j][0] = (f32x4){t[0], t[1], t[2], t[3]}; xv[j][1] = (f32x4){t[4], t[5], t[6], t[7]}; }
        unpack8(R.mr[j], mf[j]);
#pragma unroll
        for (int e = 0; e < 8; ++e) ss += mf[j][e] * mf[j][e]; }
    const float r = 1.0f / sqrtf(wave_sum(ss) * (1.0f / D) + EPS);
    float ss2 = 0.f;
#pragma unroll
    for (int j = 0; j < 4; ++j) { const f32x4 g0 = *(const f32x4*)(gpost + 512 * j + 8 * lane), g1 = *(const f32x4*)(gpost + 512 * j + 8 * lane + 4);
        const f32x4 m0 = (f32x4){mf[j][0], mf[j][1], mf[j][2], mf[j][3]}, m1 = (f32x4){mf[j][4], mf[j][5], mf[j][6], mf[j][7]};
        xv[j][0] = xv[j][0] + m0 * r * g0; xv[j][1] = xv[j][1] + m1 * r * g1;
#pragma unroll
        for (int h = 0; h < 2; ++h) { const f32x4 v = xv[j][h]; ss2 += (v[0] * v[0] + v[1] * v[1]) + (v[2] * v[2] + v[3] * v[3]); }
        if (gnext) *(u32x4*)(xb + (size_t)row * D + 512 * j + 8 * lane) = pack8(xv[j][0], xv[j][1]);
        else { *(f32x4*)(xout + (size_t)row * D + 512 * j + 8 * lane) = xv[j][0]; *(f32x4*)(xout + (size_t)row * D + 512 * j + 8 * lane + 4) = xv[j][1]; } }
    if (gnext) {
        const float r2 = 1.0f / sqrtf(wave_sum(ss2) * (1.0f / D) + EPS);
#pragma unroll
        for (int j = 0; j < 4; ++j) { const f32x4 g0 = *(const f32x4*)(gnext + 512 * j + 8 * lane), g1 = *(const f32x4*)(gnext + 512 * j + 8 * lane + 4);
            *(u32x4*)(H + (size_t)row * D + 512 * j + 8 * lane) = pack8(xv[j][0] * r2 * g0, xv[j][1] * r2 * g1); }
    }
}
__device__ __forceinline__ void resnorm_phase(const float* xp, const float* xs, bf16_t* xb, float* xout, const bf16_t* mb, const bf16_t* part, const float* gpost, const float* gnext, bf16_t* H, int gw, int NGW, int lane, LAS unsigned char* lds) {
    const bool quarter = (NGW == 4 * MS);
    if (quarter) {
        if (xp) {
            for (int row = gw; row < MP; row += 2 * NGW) { RnRow A, B;
                rn_load(A, row, xp, xb, mb, lane); rn_load(B, row + NGW, xp, xb, mb, lane);
                rn_finish(A, row, true, xb, xout, gpost, gnext, H, lane); rn_finish(B, row + NGW, true, xb, xout, gpost, gnext, H, lane); }
        } else {
            RnRow A, B, C, E;
            rn_load(A, gw, nullptr, xb, mb, lane); rn_load(B, gw + NGW, nullptr, xb, mb, lane); rn_load(C, gw + 2 * NGW, nullptr, xb, mb, lane); rn_load(E, gw + 3 * NGW, nullptr, xb, mb, lane);
            rn_finish(A, gw, false, xb, xout, gpost, gnext, H, lane); rn_finish(B, gw + NGW, false, xb, xout, gpost, gnext, H, lane);
            rn_finish(C, gw + 2 * NGW, false, xb, xout, gpost, gnext, H, lane); rn_finish(E, gw + 3 * NGW, false, xb, xout, gpost, gnext, H, lane);
        }
    }
    for (int row = gw; row < (quarter ? 0 : M); row += NGW) {
        float mf[4][8]; f32x4 xv[4][2]; float ss = 0.f;
        if (xp) { const float* xr = row < MP ? xp + (size_t)row * D : xs + (size_t)(row - MP) * D;
#pragma unroll
            for (int j = 0; j < 4; ++j) { xv[j][0] = *(const f32x4*)(xr + 512 * j + 8 * lane); xv[j][1] = *(const f32x4*)(xr + 512 * j + 8 * lane + 4); }
        } else {
#pragma unroll
            for (int j = 0; j < 4; ++j) { float t[8]; unpack8(__builtin_nontemporal_load((const u32x4*)(xb + (size_t)row * D + 512 * j + 8 * lane)), t); xv[j][0] = (f32x4){t[0], t[1], t[2], t[3]}; xv[j][1] = (f32x4){t[4], t[5], t[6], t[7]}; }
        }
#pragma unroll
        for (int j = 0; j < 4; ++j) {
            if (part && row >= MP) { const size_t o = (size_t)(row - MP) * D + 512 * j + 8 * lane; float p1[8], p2[8], p3[8];
                unpack8(__builtin_nontemporal_load((const u32x4*)(part + o)), mf[j]); unpack8(__builtin_nontemporal_load((const u32x4*)(part + (size_t)MS * D + o)), p1);
                unpack8(__builtin_nontemporal_load((const u32x4*)(part + (size_t)2 * MS * D + o)), p2); unpack8(__builtin_nontemporal_load((const u32x4*)(part + (size_t)3 * MS * D + o)), p3);
#pragma unroll
                for (int e = 0; e < 8; ++e) mf[j][e] = (mf[j][e] + p1[e]) + (p2[e] + p3[e]);
            } else unpack8(__builtin_nontemporal_load((const u32x4*)(mb + (size_t)row * D + 512 * j + 8 * lane)), mf[j]);
#pragma unroll
            for (int e = 0; e < 8; ++e) ss += mf[j][e] * mf[j][e]; }
        const float r = 1.0f / sqrtf(wave_sum(ss) * (1.0f / D) + EPS);
        float ss2 = 0.f;
#pragma unroll
        for (int j = 0; j < 4; ++j) { const f32x4 g0 = *(const f32x4*)(gpost + 512 * j + 8 * lane), g1 = *(const f32x4*)(gpost + 512 * j + 8 * lane + 4);
            const f32x4 m0 = (f32x4){mf[j][0], mf[j][1], mf[j][2], mf[j][3]}, m1 = (f32x4){mf[j][4], mf[j][5], mf[j][6], mf[j][7]};
            xv[j][0] = xv[j][0] + m0 * r * g0; xv[j][1] = xv[j][1] + m1 * r * g1;
#pragma unroll
            for (int h = 0; h < 2; ++h) { const f32x4 v = xv[j][h]; ss2 += (v[0] * v[0] + v[1] * v[1]) + (v[2] * v[2] + v[3] * v[3]); }
            if (gnext) *(u32x4*)(xb + (size_t)row * D + 512 * j + 8 * lane) = pack8(xv[j][0], xv[j][1]);
            else { *(f32x4*)(xout + (size_t)row * D + 512 * j + 8 * lane) = xv[j][0]; *(f32x4*)(xout + (size_t)row * D + 512 * j + 8 * lane + 4) = xv[j][1]; } }
        if (gnext) {
            const float r2 = 1.0f / sqrtf(wave_sum(ss2) * (1.0f / D) + EPS);
#pragma unroll
            for (int j = 0; j < 4; ++j) { const f32x4 g0 = *(const f32x4*)(gnext + 512 * j + 8 * lane), g1 = *(const f32x4*)(gnext + 512 * j + 8 * lane + 4);
                *(u32x4*)(H + (size_t)row * D + 512 * j + 8 * lane) = pack8(xv[j][0] * r2 * g0, xv[j][1] * r2 * g1); }
        }
    }
    if (quarter) {
        const int wave = (gw & 7), q = wave & 3, row = MP + (gw >> 2); const size_t off = (size_t)row * D + 512 * q + 8 * lane;
        LAS float* red = (LAS float*)lds;
        float t[8], mf[8];
        if (xp) { const float* xr = xs + (size_t)(row - MP) * D + 512 * q + 8 * lane; const f32x4 a = *(const f32x4*)xr, b = *(const f32x4*)(xr + 4); t[0] = a[0]; t[1] = a[1]; t[2] = a[2]; t[3] = a[3]; t[4] = b[0]; t[5] = b[1]; t[6] = b[2]; t[7] = b[3]; }
        else unpack8(__builtin_nontemporal_load((const u32x4*)(xb + off)), t);
        if (part) { const size_t o = off - (size_t)MP * D; float p1[8], p2[8], p3[8];
            unpack8(__builtin_nontemporal_load((const u32x4*)(part + o)), mf); unpack8(__builtin_nontemporal_load((const u32x4*)(part + (size_t)MS * D + o)), p1);
            unpack8(__builtin_nontemporal_load((const u32x4*)(part + (size_t)2 * MS * D + o)), p2); unpack8(__builtin_nontemporal_load((const u32x4*)(part + (size_t)3 * MS * D + o)), p3);
#pragma unroll
            for (int e = 0; e < 8; ++e) mf[e] = (mf[e] + p1[e]) + (p2[e] + p3[e]);
        } else unpack8(__builtin_nontemporal_load((const u32x4*)(mb + off)), mf);
        float ss = 0.f;
#pragma unroll
        for (int e = 0; e < 8; ++e) ss += mf[e] * mf[e];
        ss = wave_sum(ss);
        __syncthreads();
        if (lane == 0) red[wave] = ss;
        __syncthreads();
        const int w4 = wave & 4;
        const float r = 1.0f / sqrtf(((red[w4] + red[w4 + 1]) + (red[w4 + 2] + red[w4 + 3])) * (1.0f / D) + EPS);
        const f32x4 g0 = *(const f32x4*)(gpost + 512 * q + 8 * lane), g1 = *(const f32x4*)(gpost + 512 * q + 8 * lane + 4);
        f32x4 x0 = (f32x4){t[0], t[1], t[2], t[3]} + (f32x4){mf[0], mf[1], mf[2], mf[3]} * r * g0, x1 = (f32x4){t[4], t[5], t[6], t[7]} + (f32x4){mf[4], mf[5], mf[6], mf[7]} * r * g1;
        if (gnext) {
            *(u32x4*)(xb + off) = pack8(x0, x1);
            float ss2 = (x0[0] * x0[0] + x0[1] * x0[1]) + (x0[2] * x0[2] + x0[3] * x0[3]) + (x1[0] * x1[0] + x1[1] * x1[1]) + (x1[2] * x1[2] + x1[3] * x1[3]);
            ss2 = wave_sum(ss2);
            if (lane == 0) red[8 + wave] = ss2;
            __syncthreads();
            const float r2 = 1.0f / sqrtf(((red[8 + w4] + red[9 + w4]) + (red[10 + w4] + red[11 + w4])) * (1.0f / D) + EPS);
            const f32x4 n0 = *(const f32x4*)(gnext + 512 * q + 8 * lane), n1 = *(const f32x4*)(gnext + 512 * q + 8 * lane + 4);
            *(u32x4*)(H + off) = pack8(x0 * r2 * n0, x1 * r2 * n1);
        } else { *(f32x4*)(xout + off) = x0; *(f32x4*)(xout + off + 4) = x1; }
    }
}

__device__ __forceinline__ void sgu_phase(PP pp, LAS unsigned char* lds, int G) {
    unsigned char* ws = pp->ws;
    LAS bf16_t* Aw = (LAS bf16_t*)lds;
    LAS bf16_t* Vt = (LAS bf16_t*)(lds + 34816);
    LAS float* St = (LAS float*)(lds + 69632);
    const bf16_t* ZZ = (const bf16_t*)(ws + WS_BIG); const float* stats = (const float*)(ws + WS_STATS); bf16_t* YIN = (bf16_t*)(ws + WS_YIN);
    const float* ln_g = pp->in[12]; const float* ln_b = pp->in[13]; const float* w_s = pp->in[14]; const float* b_s = pp->in[15];
    float* st_sgu = pp->out + O_SGU;
    int tid = threadIdx.x; asm volatile("" : "+v"(tid));
    const int wid = tid >> 6, lane = tid & 63, wr = wid >> 2, wc = wid & 3, fr = lane & 15, fq = lane >> 4;
    for (int unit = blockIdx.x; unit < (M / 128) * 16; unit += G) {
        const int rt = unit >> 4, g = unit & 15, r0 = rt * 128, c0 = g * 128; const bool sample = rt >= (MP / 128);
        const int ch = lane & 15, cch = c0 + 8 * ch;
        const f32x4 lg0 = *(const f32x4*)(ln_g + cch), lg1 = *(const f32x4*)(ln_g + cch + 4), lb0 = *(const f32x4*)(ln_b + cch), lb1 = *(const f32x4*)(ln_b + cch + 4);
        u32x4 raw[4], uraw[4];
#pragma unroll
        for (int it = 0; it < 4; ++it) raw[it] = *(const u32x4*)(ZZ + (size_t)(r0 + wid * 16 + it * 4 + (lane >> 4)) * 4096 + 2048 + cch);
#pragma unroll
        for (int m = 0; m < 4; ++m) uraw[m] = *(const u32x4*)(ZZ + (size_t)(r0 + 64 * wr + 16 * m + fr) * 4096 + c0 + 32 * wc + 8 * fq);
        __syncthreads();
        if (tid < 128) { const f32x4* sp = (const f32x4*)(stats + (size_t)(r0 + tid) * 64); float s = 0.f, ss = 0.f;
#pragma unroll
            for (int q = 0; q < 16; ++q) { const f32x4 v = sp[q]; s += v[0] + v[2]; ss += v[1] + v[3]; }
            const float mean = s * (1.0f / 2048.0f), var = ss * (1.0f / 2048.0f) - mean * mean;
            St[2 * tid] = mean; St[2 * tid + 1] = 1.0f / sqrtf(fmaxf(var, 0.f) + EPS); }
        const float* wg = w_s + (size_t)g * 128 * 128;
#pragma unroll
        for (int q = 0; q < 8; ++q) { const int idx = q * NTHREADS + tid, i = idx >> 5, j4 = (idx & 31) * 4;
            int lim, so;
            if (!sample) { so = i * 128 + j4; lim = i - j4; }
            else { const int ii = i & 15, jj = j4 & 15; so = ii * 128 + jj; lim = ((i >> 4) == (j4 >> 4)) ? ii - jj : -1; }
            f32x4 w = *(const f32x4*)(wg + so);
#pragma unroll
            for (int e = 0; e < 4; ++e) w[e] = __uint_as_float(__float_as_uint(w[e]) & ~(unsigned)((lim - e) >> 31));
            u32x2 o; o.x = cvt_pk_bf16(w[0], w[1]); o.y = cvt_pk_bf16(w[2], w[3]);
            *(LAS u32x2*)(Aw + i * 136 + j4) = o; }
        __syncthreads();
        { const int c = cch;
#pragma unroll
            for (int it = 0; it < 4; ++it) { const int j = wid * 16 + it * 4 + (lane >> 4), r = r0 + j; const float mean = St[2 * j], rstd = St[2 * j + 1]; float v[8];
                unpack8(raw[it], v);
#pragma unroll
                for (int e = 0; e < 8; ++e) v[e] = (v[e] - mean) * rstd * (e < 4 ? lg0[e & 3] : lg1[e & 3]) + (e < 4 ? lb0[e & 3] : lb1[e & 3]);
                if (sample) { float* sp = st_sgu + (size_t)(r - MP) * 2048 + c; *(f32x4*)sp = (f32x4){v[0], v[1], v[2], v[3]}; *(f32x4*)(sp + 4) = (f32x4){v[4], v[5], v[6], v[7]}; }
                const int jo = (((j >> 3) ^ ch) << 3) + (j & 7);
#pragma unroll
                for (int e = 0; e < 8; e += 2) { const unsigned pk = cvt_pk_bf16(v[e], v[e + 1]); Vt[(8 * ch + e) * 136 + jo] = (bf16_t)(pk & 0xffffu); Vt[(8 * ch + e + 1) * 136 + jo] = (bf16_t)(pk >> 16); } }
        }
        __syncthreads();
        f32x4 acc[4][2];
#pragma unroll
        for (int m = 0; m < 4; ++m)
#pragma unroll
            for (int n = 0; n < 2; ++n) acc[m][n] = (f32x4){0.f, 0.f, 0.f, 0.f};
#pragma unroll
        for (int k = 0; k < 4; ++k) { bf16x8 Af[4], Bf[2];
#pragma unroll
            for (int m = 0; m < 4; ++m) Af[m] = *(const LAS bf16x8*)(Aw + (64 * wr + 16 * m + fr) * 136 + 32 * k + 8 * fq);
#pragma unroll
            for (int n = 0; n < 2; ++n) { const int d = 32 * wc + 8 * (fr >> 2) + 4 * n + (fr & 3); Bf[n] = *(const LAS bf16x8*)(Vt + d * 136 + (((4 * k + fq) ^ ((d >> 3) & 15)) << 3)); }
#pragma unroll
            for (int m = 0; m < 4; ++m)
#pragma unroll
                for (int n = 0; n < 2; ++n) acc[m][n] = __builtin_amdgcn_mfma_f32_16x16x32_bf16(Bf[n], Af[m], acc[m][n], 0, 0, 0); }
#pragma unroll
        for (int m = 0; m < 4; ++m) { const int i = 64 * wr + 16 * m + fr, r = r0 + i; const float bias = b_s[g * 128 + (sample ? (i & 15) : i)];
            const int d = c0 + 32 * wc + 8 * fq; float u[8]; unpack8(uraw[m], u);
            const f32x4 o0 = (f32x4){u[0], u[1], u[2], u[3]} * (acc[m][0] + bias), o1 = (f32x4){u[4], u[5], u[6], u[7]} * (acc[m][1] + bias);
            *(u32x4*)(YIN + (size_t)r * D + d) = pack8(o0, o1); }
    }
    __syncthreads();
}

#define XB_TMO      128
#define XB_XCNT(j)  (256  + 64 * (j))
#define XB_XSUB(j)  (1280 + 64 * (j))
#define XB_XGEN(j)  (2304 + 64 * (j))
#define XB_TOP      3328
#define XB_TOPGEN   3392
#define XCD_BAR_WORDS 3456
#define XB_SPIN_CAP (1u << 18)
__device__ __forceinline__ unsigned xb_ld(unsigned* p)              { return __hip_atomic_load(p, __ATOMIC_RELAXED, __HIP_MEMORY_SCOPE_AGENT); }
__device__ __forceinline__ unsigned xb_add(unsigned* p, unsigned v) { return __hip_atomic_fetch_add(p, v, __ATOMIC_RELAXED, __HIP_MEMORY_SCOPE_AGENT); }
__device__ __forceinline__ unsigned xb_xcc_id() { return (unsigned)__builtin_amdgcn_s_getreg((3 << 11) | 20) & 0xFu; }
#define XB_SPIN(cond, bar) do { unsigned _sp = 0; while (cond) { __builtin_amdgcn_s_sleep(1); \
    if ((++_sp & 255u) == 0u) { if (xb_ld(&(bar)[XB_TMO])) break; if (_sp > XB_SPIN_CAP) { atomicAdd(&(bar)[XB_TMO], 1u); break; } } } } while (0)
__device__ __forceinline__ void xcd_barrier_complete(unsigned* bar, unsigned x, unsigned& nloc, unsigned& nx) {
    const unsigned G = gridDim.x * gridDim.y * gridDim.z;
    unsigned sum, cnt, mine, sp = 0u;
    for (;;) {
        sum = 0u; cnt = 0u; mine = 0u;
#pragma unroll
        for (unsigned j = 0; j < 16; ++j) { const unsigned c = xb_ld(&bar[XB_XCNT(j)]); sum += c; cnt += (c > 0u) ? 1u : 0u; mine = (j == x) ? c : mine; }
        if (sum == G) break;
        __builtin_amdgcn_s_sleep(1);
        if ((++sp & 255u) == 0u) { if (xb_ld(&bar[XB_TMO])) break; if (sp > XB_SPIN_CAP) { atomicAdd(&bar[XB_TMO], 1u); break; } }
    }
    nloc = mine > 0u ? mine : 1u; nx = cnt > 0u ? cnt : 1u;
}
__device__ __forceinline__ void xcd_barrier(unsigned* bar, volatile LAS unsigned* st) {
    asm volatile("s_waitcnt vmcnt(0)" ::: "memory");
    __syncthreads();
    if (threadIdx.x == 0) {
        __builtin_amdgcn_s_waitcnt(0);
        const unsigned x = xb_xcc_id();
        unsigned nloc = st[0], nx = st[1];
        if (nloc == 0u) { xcd_barrier_complete(bar, x, nloc, nx); st[0] = nloc; st[1] = nx; }
        const unsigned old = xb_add(&bar[XB_XSUB(x)], 1u);
        const unsigned gen = old / nloc;
        if (old + 1u == (gen + 1u) * nloc) {
            __builtin_amdgcn_fence(__ATOMIC_RELEASE, "agent");
            asm volatile("s_waitcnt vmcnt(0)" ::: "memory");
            const unsigned og = xb_add(&bar[XB_TOP], 1u);
            const unsigned tg = og / nx;
            if (og + 1u == (tg + 1u) * nx) xb_add(&bar[XB_TOPGEN], 1u);
            else XB_SPIN(xb_ld(&bar[XB_TOPGEN]) == tg, bar);
            __builtin_amdgcn_fence(__ATOMIC_ACQUIRE, "agent");
            xb_add(&bar[XB_XGEN(x)], 1u);
            asm volatile("s_waitcnt vmcnt(0)" ::: "memory");
        } else {
            XB_SPIN(xb_ld(&bar[XB_XGEN(x)]) == gen, bar);
            __builtin_amdgcn_fence(__ATOMIC_ACQUIRE, "agent");
            asm volatile("s_waitcnt vmcnt(0)" ::: "memory");
        }
    }
    __syncthreads();
}

__global__ void __launch_bounds__(NTHREADS, 2) mega(Params p_arg) {
    extern __shared__ __attribute__((aligned(16))) unsigned char lds_raw[];
    LAS unsigned char* lds = (LAS unsigned char*)lds_raw;
    cg::grid_group grid = cg::this_grid();
    PP pp = (PP)__builtin_amdgcn_kernarg_segment_ptr();
    const int G = gridDim.x, NGW = G * NWAVES;
#define LANE_IDS() int tid = threadIdx.x; asm volatile("" : "+v"(tid)); const int wave = __builtin_amdgcn_readfirstlane(tid >> 6), lane = tid & 63, gw = blockIdx.x * NWAVES + wave

    if (threadIdx.x < 2) ((volatile LAS unsigned*)(lds + LDS_STAGE))[threadIdx.x] = 0u;
    if (threadIdx.x == 0) (void)xb_add(&((unsigned*)(pp->ws + WS_BAR))[XB_XCNT(xb_xcc_id())], 1u);
    if (G > 0x40000000) grid.sync();
    for (int rep = 0; rep < REP_P0; ++rep) { LANE_IDS(); phase0(pp, lds, gw, NGW, wave, lane); }
    GSYNC();

#pragma nounroll
    for (int layer = 0; layer < 2; ++layer) {
        FRESH(pp);
        if (layer == 0) {
            { unsigned char* ws = pp->ws; float* out = pp->out; bf16_t* BIG = (bf16_t*)(ws + WS_BIG);
              pg8::Gemm g{(const bf16_t*)(ws + WS_H), (const bf16_t*)(ws + WS_WAIN), M, 3 * D, D, D, 3 * D / 256}; pg8::StaticOrder S; S.init(M, 3 * D, G, (int)blockIdx.x);
              EpiCZ E{BIG, BIG + (size_t)M * D, out + O_SCP, out + O_SCS};
              for (int rep = 0; rep < REP_GEMM; ++rep) pg8::gemm_phase<EpiCZ>(lds, g, S, E);
              tail_convert(pp, lds, S.nwg, G, CV_P0, CV_T1); }
            GSYNC();
            FRESH(pp);
            for (int rep = 0; rep < REP_MIX; ++rep) conv_phase(pp, G);
            GSYNC();
        } else {
            { unsigned char* ws = pp->ws;
              pg8::Gemm g{(const bf16_t*)(ws + WS_H), (const bf16_t*)(ws + WS_WBIN), M, 2 * D, D, D, 2 * D / 256}; pg8::StaticOrder S; S.init(M, 2 * D, G, (int)blockIdx.x);
              EpiGelu E{(bf16_t*)(ws + WS_BIG), pp->in[11], (float*)(ws + WS_STATS)};
              for (int rep = 0; rep < REP_GEMM; ++rep) pg8::gemm_phase<EpiGelu>(lds, g, S, E);
              tail_convert(pp, lds, S.nwg, G, CV_T3, CV_T8); }
            GSYNC();
            FRESH(pp);
            for (int rep = 0; rep < REP_MIX; ++rep) sgu_phase(pp, lds, G);
            GSYNC();
        }
#pragma nounroll
        for (int sub = 0; sub < 2; ++sub) {
            if (sub == 1) {
                FRESH(pp);
                unsigned char* ws = pp->ws;
                pg8::Gemm g{(const bf16_t*)(ws + WS_H), (const bf16_t*)(ws + (layer ? WS_WGU1 : WS_WGU0)), M, 2 * FF, D, D, 2 * FF / 256}; pg8::StaticOrder S; S.init(M, 2 * FF, G, (int)blockIdx.x);
                EpiGU E{(bf16_t*)(ws + WS_BIG)};
                for (int rep = 0; rep < REP_GEMM; ++rep) pg8::gemm_phase<EpiGU>(lds, g, S, E);
                GSYNC();
            }
            { FRESH(pp);
              unsigned char* ws = pp->ws;
              const bf16_t* A = (const bf16_t*)(ws + (sub ? WS_BIG : WS_YIN)); const int K = sub ? FF : D;
              const bf16_t* Bt = (const bf16_t*)(ws + (sub ? (layer ? WS_WDN1 : WS_WDN0) : (layer ? WS_WBOUT : WS_WAOUT)));
              bf16_t* MB = (bf16_t*)(ws + WS_MB); bf16_t* PT = (bf16_t*)(ws + WS_PART);
              { pg8::Gemm g{A, Bt, MP, D, K, K, D / 256}; pg8::StaticOrder S; S.init(MP, D, G, (int)blockIdx.x);
                EpiPlain E{MB, MB, MB, MB, D, D / 256};
                pg8::gemm_phase<EpiPlain>(lds, g, S, E); }
              const int ks = 4;
              { pg8::Gemm g{A + (size_t)MP * K, Bt, MS, D * ks, K / ks, K, D / 256}; pg8::StaticOrder S; S.init(MS, D * ks, G, (int)blockIdx.x);
                bf16_t* MBS = MB + (size_t)MP * D;
                EpiPlain E{ks == 1 ? MBS : PT, PT + (size_t)MS * D, PT + (size_t)2 * MS * D, PT + (size_t)3 * MS * D, D, D / 256};
                pg8::gemm_phase<EpiPlain>(lds, g, S, E);
                { const int lo = layer == 0 ? (sub ? CV_T1 + I_DN : CV_T1) : CV_T8, hi = layer == 0 ? (sub ? CV_T3 : CV_T1 + I_DN) : (sub ? CV_T8 : CV_T10);
                  tail_convert(pp, lds, G + S.nwg, G, lo, hi); } } }
            GSYNC();
            { FRESH(pp); LANE_IDS();
              unsigned char* ws = pp->ws;
              const bool first = (layer == 0 && sub == 0), lastp = (layer == 1 && sub == 1);
              const float* xp = first ? pp->in[0] : nullptr; const float* xs = first ? pp->in[1] : nullptr;
              const float* gpost = (sub ? pp->in[6] : pp->in[4]) + layer * D;
              const float* gnext = lastp ? nullptr : (sub ? pp->in[3] + D : pp->in[5] + layer * D);
              resnorm_phase(xp, xs, (bf16_t*)(ws + WS_XB), pp->out + O_Y, (const bf16_t*)(ws + WS_MB), (const bf16_t*)(ws + WS_PART), gpost, gnext, (bf16_t*)(ws + WS_H), gw, NGW, lane, lds); }
            if (!(layer == 1 && sub == 1)) GSYNC();
        }
    }
}

extern "C" void kernel_launch(void* const* d_in, const int* in_sizes, int n_in, void* d_out, int out_size, void* d_ws, size_t ws_size, hipStream_t stream) {
    static int grid = 0;
    if (grid == 0) {
        if (ws_size < WS_END) { fprintf(stderr, "kernel_launch: workspace too small: %zu < %zu\n", ws_size, (size_t)WS_END); grid = -1; return; }
        int dev = 0, cus = 0, per_cu = 0;
        (void)hipGetDevice(&dev);
        (void)hipDeviceGetAttribute(&cus, hipDeviceAttributeMultiprocessorCount, dev);
        if (hipFuncSetAttribute((const void*)mega, hipFuncAttributeMaxDynamicSharedMemorySize, LDS_BYTES) != hipSuccess) fprintf(stderr, "kernel_launch: hipFuncSetAttribute failed\n");
        if (hipOccupancyMaxActiveBlocksPerMultiprocessor(&per_cu, (const void*)mega, NTHREADS, LDS_BYTES) != hipSuccess || per_cu < 1) per_cu = 1;
        (void)hipGetLastError();
        grid = cus * per_cu;
    }
    if (grid < 0) return;
    if (hipMemsetAsync((char*)d_ws + WS_BAR, 0, XCD_BAR_WORDS * 4, stream) != hipSuccess) fprintf(stderr, "kernel_launch: memset of the barrier words failed\n");
    Params p{};
    for (int i = 0; i < 20; ++i) p.in[i] = (const float*)d_in[i];
    p.out = (float*)d_out; p.ws = (unsigned char*)d_ws;
    void* args[] = {&p};
    hipError_t e = hipLaunchCooperativeKernel((const void*)mega, dim3(grid), dim3(NTHREADS), args, LDS_BYTES, stream);
    if (e != hipSuccess) fprintf(stderr, "cooperative launch failed: %s (grid %d)\n", hipGetErrorString(e), grid);
}
```
